# Optimizing an MI355X kernel written in HIP

```python
import math
import jax, jax.numpy as jnp
from jax import lax
import numpy as np

D_MODEL = 1024
BATCH = 1
SEQ = 16384
DEPTH = 1
DEC_BATCH = 16
DEC_SEQ = 16
PAST_LEN = 4096

CHUNK = 64
QBLOCK = 128
N_HEADS = 8
QK_NOPE = 64
QK_ROPE = 32
V_DIM = 64
Q_LORA = 256
KV_LORA = 256
ROPE_THETA = 10000.0
MLA_WIDTH = N_HEADS * V_DIM
ATTN_SCALE = 1.0 / math.sqrt(QK_NOPE + QK_ROPE)
POOL_WINDOWS = (2, 4, 8, 16)
N_POOL_GROUPS = 4
POOL_WIDTH = D_MODEL - MLA_WIDTH
POOL_GROUP_W = POOL_WIDTH // N_POOL_GROUPS
POOL_HIST = max(POOL_WINDOWS) - 1
IN_WIDTH = Q_LORA + KV_LORA + QK_ROPE + POOL_WIDTH
D_FF = 2816
CONV_W = 3
PLE_DIM = 256
ALPHA = (2 * DEPTH) ** 0.25
BETA = (8 * DEPTH) ** -0.25
LN_EPS = 1e-5
RMS_EPS = 1e-6
NEG = -1e30

kernel_name = "mla_pool_convffn_deepnorm_stream_step"


def rms_norm(x, g):
    xf = x.astype(jnp.float32)
    y = xf * lax.rsqrt(jnp.mean(xf * xf, axis=-1, keepdims=True) + RMS_EPS)
    return (y * g.astype(jnp.float32)).astype(x.dtype)


def layer_norm(x, g, b):
    xf = x.astype(jnp.float32)
    mu = jnp.mean(xf, axis=-1, keepdims=True)
    var = jnp.mean(jnp.square(xf - mu), axis=-1, keepdims=True)
    y = (xf - mu) * lax.rsqrt(var + LN_EPS)
    return (y * g.astype(jnp.float32) + b.astype(jnp.float32)).astype(x.dtype)


def rope_tables(pos):
    inv = 1.0 / (ROPE_THETA ** (jnp.arange(0, QK_ROPE, 2, dtype=jnp.float32) / QK_ROPE))
    ang = pos.astype(jnp.float32)[:, None] * inv[None, :]
    return jnp.cos(ang), jnp.sin(ang)


def apply_rope(x, cos, sin):
    half = x.shape[-1] // 2
    x1, x2 = x[..., :half], x[..., half:]
    c, s = cos.astype(x.dtype), sin.astype(x.dtype)
    return jnp.concatenate([x1 * c - x2 * s, x2 * c + x1 * s], axis=-1)


def prompt_attention(q, k, v, pos):
    B, S, H, Dk = q.shape
    nb = S // QBLOCK
    qb = q.reshape(B, nb, QBLOCK, H, Dk).transpose(1, 0, 2, 3, 4)
    k_chunk = pos // CHUNK
    q_chunk = (pos // CHUNK).reshape(nb, QBLOCK)

    def one_block(args):
        qi, qc = args
        s = jnp.einsum('bqhd,bkhd->bhqk', qi, k).astype(jnp.float32) * ATTN_SCALE
        mask = k_chunk[None, :] <= qc[:, None]
        s = jnp.where(mask[None, None], s, NEG)
        p = jax.nn.softmax(s, axis=-1).astype(v.dtype)
        return jnp.einsum('bhqk,bkhd->bqhd', p, v)

    o = lax.map(one_block, (qb, q_chunk))
    return o.transpose(1, 0, 2, 3, 4).reshape(B, S, H, V_DIM)


def sample_attention(q_nope, q_rope, c_all, kr_all, w_kv_b, q_pos):
    L = c_all.shape[1]
    w = w_kv_b.reshape(KV_LORA, N_HEADS, QK_NOPE + V_DIM)
    w_uk, w_uv = w[..., :QK_NOPE], w[..., QK_NOPE:]
    q_lat = jnp.einsum('bqhn,lhn->bqhl', q_nope, w_uk)
    s = (jnp.einsum('bqhl,bkl->bhqk', q_lat, c_all)
         + jnp.einsum('bqhr,bkr->bhqk', q_rope, kr_all)).astype(jnp.float32) * ATTN_SCALE
    mask = (jnp.arange(L) // CHUNK)[None, :] <= (q_pos // CHUNK)[:, None]
    s = jnp.where(mask[None, None], s, NEG)
    p = jax.nn.softmax(s, axis=-1).astype(c_all.dtype)
    o_lat = jnp.einsum('bhqk,bkl->bqhl', p, c_all)
    return jnp.einsum('bqhl,lhv->bqhv', o_lat, w_uv)


def pool_mix(u_ext, n_hist, pos0, w_pool, s_pool):
    B, L, _ = u_ext.shape
    T = L - n_hist
    G, C = N_POOL_GROUPS, POOL_GROUP_W
    ug = u_ext.astype(jnp.float32).reshape(B, L, G, C)
    cs = jnp.concatenate([jnp.zeros((B, 1, G, C), jnp.float32), jnp.cumsum(ug, axis=1)], axis=1)
    win = np.array(POOL_WINDOWS, dtype=np.int32)
    j = np.arange(T, dtype=np.int32)[:, None]
    hi = np.broadcast_to(n_hist + j + 1, (T, G))
    lo = np.maximum(hi - win[None, :], 0)
    cnt = np.minimum(win[None, :], pos0 + j + 1).astype(np.float32)
    gi = np.arange(G)[None, :]
    win_sum = cs[:, hi, gi] - cs[:, lo, gi]
    d = win_sum / jnp.asarray(cnt)[None, :, :, None] - ug[:, n_hist:]
    y = jnp.einsum('btgc,gcd->btgd', d.astype(u_ext.dtype), w_pool)
    return y.reshape(B, T, POOL_WIDTH) * s_pool


def conv_ffn(h, conv_hist, w_up, w_dw, b_dw, w_down):
    up = h @ w_up
    T = up.shape[1]
    ext = jnp.concatenate([conv_hist.astype(up.dtype), up], axis=1)
    c = ext[:, 0:T] * w_dw[0] + ext[:, 1:T + 1] * w_dw[1] + ext[:, 2:T + 2] * w_dw[2] + b_dw
    a, b = jnp.split(c, 2, axis=-1)
    return (jax.nn.silu(a) * b) @ w_down, ext[:, -(CONV_W - 1):]


def layer(x, pe, pos0, ckv_hist, kr_hist, pool_hist, conv_hist, lp):
    (w_in, g_q, w_q_b, g_kv, w_kv_b, w_pool, s_pool, w_o, ln1_g, ln1_b,
     w_up, w_dw, b_dw, w_down, w_pg, w_pe, ln2_g, ln2_b) = lp
    B, T, _ = x.shape
    pos = pos0 + jnp.arange(T, dtype=jnp.int32)
    cos, sin = rope_tables(pos)
    z = x @ w_in
    q_a, c_raw, kr_raw, u = jnp.split(z, [Q_LORA, Q_LORA + KV_LORA, Q_LORA + KV_LORA + QK_ROPE], axis=-1)
    q = (rms_norm(q_a, g_q) @ w_q_b).reshape(B, T, N_HEADS, QK_NOPE + QK_ROPE)
    q_nope = q[..., :QK_NOPE]
    q_rope = apply_rope(q[..., QK_NOPE:], cos[:, None, :], sin[:, None, :])
    c = rms_norm(c_raw, g_kv)
    kr = apply_rope(kr_raw, cos, sin)
    if ckv_hist is None:
        kv = (c @ w_kv_b).reshape(B, T, N_HEADS, QK_NOPE + V_DIM)
        k = jnp.concatenate([kv[..., :QK_NOPE],
                             jnp.broadcast_to(kr[:, :, None, :], (B, T, N_HEADS, QK_ROPE))], axis=-1)
        qf = jnp.concatenate([q_nope, q_rope], axis=-1)
        o = prompt_attention(qf, k, kv[..., QK_NOPE:], pos)
        u_ext, n_hist = u, 0
    else:
        c_all = jnp.concatenate([ckv_hist.astype(c.dtype), c], axis=1)
        kr_all = jnp.concatenate([kr_hist.astype(kr.dtype), kr], axis=1)
        o = sample_attention(q_nope, q_rope, c_all, kr_all, w_kv_b, pos)
        u_ext, n_hist = jnp.concatenate([pool_hist.astype(u.dtype), u], axis=1), POOL_HIST
    pool_out = pool_mix(u_ext, n_hist, pos0, w_pool, s_pool)
    new_pool = u_ext[:, -POOL_HIST:]
    mix = jnp.concatenate([o.reshape(B, T, MLA_WIDTH), pool_out], axis=-1) @ w_o
    x1 = layer_norm(ALPHA * x + mix, ln1_g, ln1_b)
    ffn, new_conv = conv_ffn(x1, conv_hist, w_up, w_dw, b_dw, w_down)
    ple = jax.nn.sigmoid(x1 @ w_pg) * (pe @ w_pe)
    x2 = layer_norm(ALPHA * x1 + ffn + ple, ln2_g, ln2_b)
    return x2, c, kr, new_pool, new_conv


def setup_inputs(seed: int = 0) -> dict:
    key = jax.random.key(seed)
    ks = jax.random.split(key, 32)
    f32 = jnp.float32
    nrm = lambda k, shape, std: jax.random.normal(k, shape, f32) * std
    return {
        "x_prompt": nrm(ks[0], (BATCH, SEQ, D_MODEL), 1.0),
        "x_sample": nrm(ks[1], (DEC_BATCH, DEC_SEQ, D_MODEL), 1.0),
        "cache_ckv": nrm(ks[2], (DEPTH, DEC_BATCH, PAST_LEN, KV_LORA), 1.0),
        "cache_krope": nrm(ks[3], (DEPTH, DEC_BATCH, PAST_LEN, QK_ROPE), 1.0),
        "state_pool": nrm(ks[4], (DEPTH, DEC_BATCH, POOL_HIST, POOL_WIDTH), 1.0),
        "state_ffn_conv": nrm(ks[5], (DEPTH, DEC_BATCH, CONV_W - 1, 2 * D_FF), 1.0),
        "p_prompt": nrm(ks[6], (DEPTH, BATCH, SEQ, PLE_DIM), 1.0),
        "p_sample": nrm(ks[7], (DEPTH, DEC_BATCH, DEC_SEQ, PLE_DIM), 1.0),
        "w_in": nrm(ks[8], (DEPTH, D_MODEL, IN_WIDTH), D_MODEL ** -0.5),
        "g_q": 1.0 + nrm(ks[9], (DEPTH, Q_LORA), 0.02),
        "w_q_b": nrm(ks[10], (DEPTH, Q_LORA, N_HEADS * (QK_NOPE + QK_ROPE)), Q_LORA ** -0.5),
        "g_kv": 1.0 + nrm(ks[11], (DEPTH, KV_LORA), 0.02),
        "w_kv_b": nrm(ks[12], (DEPTH, KV_LORA, N_HEADS * (QK_NOPE + V_DIM)), KV_LORA ** -0.5),
        "w_pool": nrm(ks[13], (DEPTH, N_POOL_GROUPS, POOL_GROUP_W, POOL_GROUP_W), POOL_GROUP_W ** -0.5),
        "s_pool": 1.0 + nrm(ks[14], (DEPTH, POOL_WIDTH), 0.02),
        "w_o": nrm(ks[15], (DEPTH, D_MODEL, D_MODEL), BETA * D_MODEL ** -0.5),
        "ln1_g": 1.0 + nrm(ks[16], (DEPTH, D_MODEL), 0.02),
        "ln1_b": nrm(ks[17], (DEPTH, D_MODEL), 0.02),
        "w_up": nrm(ks[18], (DEPTH, D_MODEL, 2 * D_FF), D_MODEL ** -0.5),
        "w_dw": nrm(ks[19], (DEPTH, CONV_W, 2 * D_FF), CONV_W ** -0.5),
        "b_dw": nrm(ks[20], (DEPTH, 2 * D_FF), 0.02),
        "w_down": nrm(ks[21], (DEPTH, D_FF, D_MODEL), BETA * D_FF ** -0.5),
        "w_pg": nrm(ks[22], (DEPTH, D_MODEL, D_MODEL), D_MODEL ** -0.5),
        "w_pe": nrm(ks[23], (DEPTH, PLE_DIM, D_MODEL), BETA * PLE_DIM ** -0.5),
        "ln2_g": 1.0 + nrm(ks[24], (DEPTH, D_MODEL), 0.02),
        "ln2_b": nrm(ks[25], (DEPTH, D_MODEL), 0.02),
    }


def reference(x_prompt, x_sample, cache_ckv, cache_krope, state_pool, state_ffn_conv, p_prompt, p_sample,
              w_in, g_q, w_q_b, g_kv, w_kv_b, w_pool, s_pool, w_o, ln1_g, ln1_b,
              w_up, w_dw, b_dw, w_down, w_pg, w_pe, ln2_g, ln2_b):
    n_past = cache_ckv.shape[2]
    hp, hs = x_prompt, x_sample
    ckv_p, kr_p, pool_p, conv_p = [], [], [], []
    ckv_s, kr_s, pool_s, conv_s = [], [], [], []
    for i in range(DEPTH):
        lp = (w_in[i], g_q[i], w_q_b[i], g_kv[i], w_kv_b[i], w_pool[i], s_pool[i], w_o[i],
              ln1_g[i], ln1_b[i], w_up[i], w_dw[i], b_dw[i], w_down[i], w_pg[i], w_pe[i],
              ln2_g[i], ln2_b[i])
        zero_conv = jnp.zeros((hp.shape[0], CONV_W - 1, 2 * D_FF), hp.dtype)
        hp, c1, k1, pl1, cv1 = layer(hp, p_prompt[i], 0, None, None, None, zero_conv, lp)
        hs, c2, k2, pl2, cv2 = layer(hs, p_sample[i], n_past, cache_ckv[i], cache_krope[i],
                                     state_pool[i], state_ffn_conv[i], lp)
        ckv_p.append(c1); kr_p.append(k1); pool_p.append(pl1); conv_p.append(cv1)
        ckv_s.append(c2); kr_s.append(k2); pool_s.append(pl2); conv_s.append(cv2)
    return (hp, hs,
            jnp.stack(ckv_p), jnp.stack(kr_p), jnp.stack(pool_p), jnp.stack(conv_p),
            jnp.stack(ckv_s), jnp.stack(kr_s), jnp.stack(pool_s), jnp.stack(conv_s))
```

```cpp
#include <hip/hip_runtime.h>
#include <hip/hip_cooperative_groups.h>
#include <cstdio>
#include <cstdint>
namespace cg = cooperative_groups;

typedef unsigned short u16;
typedef __attribute__((ext_vector_type(8))) short bf16x8;
typedef __attribute__((ext_vector_type(4))) short s16x4;
typedef __attribute__((ext_vector_type(16))) float f32x16;
typedef __attribute__((ext_vector_type(2))) float f32x2;
typedef __attribute__((ext_vector_type(4))) unsigned u32x4;
typedef __attribute__((ext_vector_type(4))) float f32x4;
typedef __attribute__((ext_vector_type(2))) __bf16 bf2_t;
#define DI __device__ __forceinline__
__device__ __forceinline__ int opaque_tid() { int t = threadIdx.x; asm volatile("" : "+v"(t)); return t; }
#define TID8 opaque_tid()
#define TIDX (opaque_tid() & 255)
#define HB (opaque_tid() >> 8)
#define VB ((int)(blockIdx.x * 2 + HB))
#define VG ((int)(gridDim.x * 2))
#define MFMA(a, b, c) __builtin_amdgcn_mfma_f32_32x32x16_bf16((a), (b), (c), 0, 0, 0)
#define LDS3(T, p) ((__attribute__((address_space(3))) T*)(p))

constexpr int TP = 16384, TS = 256, TT = TP + TS;
constexpr int DM = 1024, INW = 1056, DFF = 2816, DFF2 = 5632;
constexpr int NSP = 4;
constexpr float ALPHA_F = 1.189207115002721f;
constexpr float QSCALE = 0.10206207261596577f * 1.4426950408889634f;

constexpr size_t O_Y = 0;
constexpr size_t O_CKVP = (size_t)TT * 1024;
constexpr size_t O_KRP = O_CKVP + (size_t)TP * 256;
constexpr size_t O_POOLP = O_KRP + (size_t)TP * 32;
constexpr size_t O_CONVP = O_POOLP + 15 * 512;
constexpr size_t O_CKVS = O_CONVP + 2 * DFF2;
constexpr size_t O_KRS = O_CKVS + (size_t)TS * 256;
constexpr size_t O_POOLS = O_KRS + (size_t)TS * 32;
constexpr size_t O_CONVS = O_POOLS + 16 * 15 * 512;

constexpr size_t al(size_t x) { return (x + 255) & ~(size_t)255; }
constexpr size_t W_CNT = 0;
constexpr size_t W_ROPE = 4096;
constexpr size_t W_WINT = W_ROPE + (size_t)16384 * 16 * 8;
constexpr size_t W_WQB = W_WINT + (size_t)1152 * 1024 * 2;
constexpr size_t W_WQBT = W_WQB + (size_t)256 * 768 * 2;
constexpr size_t W_WKVB = W_WQBT + (size_t)768 * 256 * 2;
constexpr size_t W_WKVBT = W_WKVB + (size_t)256 * 1024 * 2;
constexpr size_t W_WPOOLT = W_WKVBT + (size_t)1024 * 256 * 2;
constexpr size_t W_WOT = W_WPOOLT + (size_t)128 * 512 * 2;
constexpr size_t W_WUPT = W_WOT + (size_t)1024 * 1024 * 2;
constexpr size_t W_WDOWNT = W_WUPT + (size_t)5632 * 1024 * 2;
constexpr size_t W_WPGT = W_WDOWNT + (size_t)1024 * 2816 * 2;
constexpr size_t W_WPET = W_WPGT + (size_t)1024 * 1024 * 2;
constexpr size_t W_WQLT = W_WPET + (size_t)1024 * 256 * 2;
constexpr size_t W_PEB = W_WQLT + (size_t)2048 * 256 * 2;
constexpr size_t W_R = al(W_PEB + (size_t)TT * 256 * 2);
constexpr size_t W_XB = W_R;
constexpr size_t W_Z = al(W_XB + (size_t)TT * 1024 * 2);
constexpr size_t W_R2 = al(W_Z + (size_t)TT * INW * 4);
constexpr size_t W_QN = W_R2;
constexpr size_t W_CB = al(W_QN + (size_t)TT * 256 * 2);
constexpr size_t W_DB = al(W_CB + (size_t)TT * 256 * 2);
constexpr size_t W_KRB = al(W_DB + (size_t)TT * 512 * 2);
constexpr size_t W_END1 = al(W_KRB + (size_t)TP * 32 * 2);
constexpr size_t W_QBUF = W_R;
constexpr size_t W_KG = al(W_QBUF + (size_t)TT * 768 * 2);
constexpr size_t W_VT = al(W_KG + (size_t)8 * TP * 96 * 2);
constexpr size_t W_QLAT = al(W_VT + (size_t)8 * 64 * TP * 2);
constexpr size_t W_OBUF = al(W_QLAT + (size_t)TS * 2048 * 2);
static_assert(W_OBUF + (size_t)TT * 1024 * 2 <= W_R2, "mid overlay overflow");
constexpr size_t W_OPART = W_R2;
constexpr size_t W_ML = al(W_OPART + (size_t)16 * NSP * 128 * 256 * 4);
static_assert(W_ML + (size_t)16 * NSP * 128 * 2 * 4 <= W_END1, "partials overflow");
constexpr size_t W_X1B = W_R;
constexpr size_t W_ACT = al(W_X1B + (size_t)TT * 1024 * 2);
constexpr size_t W_PLE = al(W_ACT + (size_t)TT * DFF * 2);
constexpr size_t W_END2 = al(W_PLE + (size_t)TT * 1024 * 2);
constexpr size_t W_BAR = W_END1 > W_END2 ? W_END1 : W_END2;
constexpr size_t W_TOTAL = W_BAR + 16384;
static_assert(W_TOTAL <= (size_t)256 * 1024 * 1024, "workspace over 256 MiB");

constexpr int HALF_BYTES = 73728;
constexpr int SMEM_BYTES = 2 * HALF_BYTES;

struct Params { const float* in[26]; float* out; char* ws; };

DI unsigned pk2(float a, float b) { f32x2 v = {a, b}; return __builtin_bit_cast(unsigned, __builtin_convertvector(v, bf2_t)); }
DI u16 bf1(float a) { return (u16)(pk2(a, 0.f) & 0xffffu); }
DI float bf2f(u16 v) { return __uint_as_float(((unsigned)v) << 16); }
DI float wave_sum(float v) { for (int o = 32; o > 0; o >>= 1) v += __shfl_xor(v, o); return v; }
DI float fexp2(float x) { return __builtin_amdgcn_exp2f(x); }
DI float4 nt_ld4(const float4* p) { const f32x4 t = __builtin_nontemporal_load((const f32x4*)p); return make_float4(t[0], t[1], t[2], t[3]); }
DI void nt_st4(float4* p, const float4& v) { const f32x4 t = {v.x, v.y, v.z, v.w}; __builtin_nontemporal_store(t, (f32x4*)p); }
DI float half_max(float v) { auto r = __builtin_amdgcn_permlane32_swap(__float_as_uint(v), __float_as_uint(v), false, false); return fmaxf(__uint_as_float(r[0]), __uint_as_float(r[1])); }
DI float half_sum(float v) { auto r = __builtin_amdgcn_permlane32_swap(__float_as_uint(v), __float_as_uint(v), false, false); return __uint_as_float(r[0]) + __uint_as_float(r[1]); }

template <bool GUARD = false>
DI void gemm_main(const u16* __restrict__ A, size_t lda, int rlo, int rhi,
                  const u16* __restrict__ B0, const u16* __restrict__ B1, size_t ldb,
                  int K, f32x16 (&acc)[2][2], char* smem) {
  const int tid = TIDX, lane = tid & 63, wave = tid >> 6;
  const int wm = wave >> 1, wn = wave & 1, r = lane & 31, h = lane >> 5;
  const int crow = tid >> 3, kc = tid & 7;
  const u16* pa[4];
#pragma unroll
  for (int i = 0; i < 4; ++i) {
    int rw = crow + 32 * i;
    if (GUARD) rw = rw < rlo ? rlo : (rw >= rhi ? rhi - 1 : rw);
    pa[i] = A + (ptrdiff_t)rw * (ptrdiff_t)lda + kc * 8;
  }
  const u16* pb0 = B0 + (size_t)crow * ldb + kc * 8;
  const u16* pb1 = B1 + (size_t)crow * ldb + kc * 8;
  bool va[4];
#pragma unroll
  for (int i = 0; i < 4; ++i) va[i] = (crow + 32 * i >= rlo) && (crow + 32 * i < rhi);
  u32x4 ra0[4], rb0[4], ra1[4], rb1[4];
  const int nk = K >> 6;
  const u32x4 zz = {0u, 0u, 0u, 0u};
#define G_LOAD(RA, RB, KT)                                                                     \
  {                                                                                            \
    const int k0_ = (KT) << 6;                                                                 \
    _Pragma("unroll") for (int i = 0; i < 4; ++i) {                                            \
      const u32x4 t_ = *(const u32x4*)(pa[i] + k0_);                                           \
      RA[i] = (!GUARD || va[i]) ? t_ : zz;                                                     \
    }                                                                                          \
    RB[0] = *(const u32x4*)(pb0 + k0_);                                                        \
    RB[1] = *(const u32x4*)(pb0 + 32 * ldb + k0_);                                             \
    RB[2] = *(const u32x4*)(pb1 + k0_);                                                        \
    RB[3] = *(const u32x4*)(pb1 + 32 * ldb + k0_);                                             \
    __builtin_amdgcn_sched_barrier(0);                                                         \
  }
#define G_WRITE(RA, RB, ST)                                                                    \
  {                                                                                            \
    char* as_ = smem + (ST) * 36864 + crow * 144 + kc * 16;                                    \
    __builtin_amdgcn_sched_barrier(0);                                                         \
    _Pragma("unroll") for (int i = 0; i < 4; ++i) *(u32x4*)(as_ + i * 32 * 144) = RA[i];        \
    _Pragma("unroll") for (int i = 0; i < 4; ++i) *(u32x4*)(as_ + 18432 + i * 32 * 144) = RB[i]; \
    __builtin_amdgcn_sched_barrier(0);                                                         \
  }
#define G_COMPUTE(ST)                                                                          \
  {                                                                                            \
    const char* as_ = smem + (ST) * 36864 + (wm * 64 + r) * 144 + h * 16;                      \
    const char* bs_ = smem + (ST) * 36864 + 18432 + (wn * 64 + r) * 144 + h * 16;              \
    bf16x8 fa[2], fb[2][2];          \
    fb[0][0] = *(const bf16x8*)(bs_);                                                          \
    fb[0][1] = *(const bf16x8*)(bs_ + 32 * 144);                                               \
    fa[0] = *(const bf16x8*)(as_);                                                             \
    fa[1] = *(const bf16x8*)(as_ + 32 * 144);                                                  \
    _Pragma("unroll") for (int ks = 0; ks < 4; ++ks) {                                         \
      if (ks < 3) {                                                                            \
        fb[(ks + 1) & 1][0] = *(const bf16x8*)(bs_ + (ks + 1) * 32);                           \
        fb[(ks + 1) & 1][1] = *(const bf16x8*)(bs_ + 32 * 144 + (ks + 1) * 32);                \
      }                                                                                        \
      _Pragma("unroll") for (int mi = 0; mi < 2; ++mi) {                                       \
        acc[mi][0] = MFMA(fa[mi], fb[ks & 1][0], acc[mi][0]);                                  \
        acc[mi][1] = MFMA(fa[mi], fb[ks & 1][1], acc[mi][1]);                                  \
        if (ks < 3) fa[mi] = *(const bf16x8*)(as_ + mi * 32 * 144 + (ks + 1) * 32);            \
      }                                                                                        \
    }                                                                                          \
  }
  if (nk == 1) {
    G_LOAD(ra0, rb0, 0)
    G_WRITE(ra0, rb0, 0)
    __syncthreads();
    G_COMPUTE(0)
    __syncthreads();
    return;
  }
  G_LOAD(ra0, rb0, 0)
  G_LOAD(ra1, rb1, 1)
  G_WRITE(ra0, rb0, 0)
  G_LOAD(ra0, rb0, (2 < nk ? 2 : nk - 1))
  __syncthreads();
  for (int kt = 0; kt + 2 < nk; kt += 2) {
    G_WRITE(ra1, rb1, 1)
    G_LOAD(ra1, rb1, kt + 3)
    G_COMPUTE(0)
    __syncthreads();
    G_WRITE(ra0, rb0, 0)
    G_LOAD(ra0, rb0, (kt + 4 < nk ? kt + 4 : nk - 1))
    G_COMPUTE(1)
    __syncthreads();
  }
  G_WRITE(ra1, rb1, 1)
  G_COMPUTE(0)
  __syncthreads();
  G_COMPUTE(1)
  __syncthreads();
}

DI bool raster(int it, int NRT, int NCT, int& rt, int& ct) {
  const int b = blockIdx.x, per = gridDim.x >> 3;
  const int ord = (it * 8 + (b & 7)) * per + (b >> 3);
  const int sr = ord / (8 * NCT), rem = ord - sr * 8 * NCT;
  ct = rem >> 3;
  rt = sr * 8 + (rem & 7);
  return sr < ((NRT + 7) >> 3);
}


template <bool GUARD = false>
DI void gemm256(const u16* __restrict__ A, size_t lda, int rlo, int rhi,
                const u16* __restrict__ B0, const u16* __restrict__ B1, size_t ldb,
                int K, f32x16 (&acc)[4][2], char* smem) {
  const int tid = TID8, lane = tid & 63, wave = tid >> 6;
  const int wm = wave >> 2, wn = wave & 3, r = lane & 31, h = lane >> 5;
  const int crow = tid >> 3, kc = tid & 7;
  const u16* pa[4];
  bool va[4];
#pragma unroll
  for (int i = 0; i < 4; ++i) {
    int rw = crow + 64 * i;
    va[i] = (rw >= rlo) && (rw < rhi);
    if (GUARD) rw = rw < rlo ? rlo : (rw >= rhi ? rhi - 1 : rw);
    pa[i] = A + (ptrdiff_t)rw * (ptrdiff_t)lda + kc * 8;
  }
  const u16* pb0 = B0 + (size_t)crow * ldb + kc * 8;
  const u16* pb1 = B1 + (size_t)crow * ldb + kc * 8;
  u32x4 ra[4], rb[4];
  const int nk = K >> 6;
  const u32x4 zz = {0u, 0u, 0u, 0u};
#define H_LOADA(KT)                                                                            \
  {                                                                                            \
    const int k0_ = (KT) << 6;                                                                 \
    _Pragma("unroll") for (int i = 0; i < 4; ++i) {                                            \
      const u32x4 t_ = *(const u32x4*)(pa[i] + k0_);                                           \
      ra[i] = (!GUARD || va[i]) ? t_ : zz;                                                     \
    }                                                                                          \
    __builtin_amdgcn_sched_barrier(0);                                                         \
  }
#define H_LOADB(KT)                                                                            \
  {                                                                                            \
    const int k0_ = (KT) << 6;                                                                 \
    rb[0] = *(const u32x4*)(pb0 + k0_);                                                        \
    rb[1] = *(const u32x4*)(pb0 + 64 * ldb + k0_);                                             \
    rb[2] = *(const u32x4*)(pb1 + k0_);                                                        \
    rb[3] = *(const u32x4*)(pb1 + 64 * ldb + k0_);                                             \
    __builtin_amdgcn_sched_barrier(0);                                                         \
  }
#define H_LOAD(KT) { H_LOADA(KT) H_LOADB(KT) }
#define H_WRITE(ST)                                                                            \
  {                                                                                            \
    char* as_ = smem + (ST) * 73728 + crow * 144 + kc * 16;                                    \
    __builtin_amdgcn_sched_barrier(0);                                                         \
    _Pragma("unroll") for (int i = 0; i < 4; ++i) *(u32x4*)(as_ + i * 64 * 144) = ra[i];        \
    _Pragma("unroll") for (int i = 0; i < 4; ++i) *(u32x4*)(as_ + 36864 + i * 64 * 144) = rb[i]; \
    __builtin_amdgcn_sched_barrier(0);                                                         \
  }
#define H_FRAGS(FA, FB, KS)                                                                    \
  {                                                                                            \
    FB[0] = *(const bf16x8*)(bs_ + (KS) * 32);                                                 \
    FB[1] = *(const bf16x8*)(bs_ + 32 * 144 + (KS) * 32);                                      \
    _Pragma("unroll") for (int mi = 0; mi < 4; ++mi) FA[mi] = *(const bf16x8*)(as_ + mi * 32 * 144 + (KS) * 32); \
  }
#define H_MFMAS(FA, FB)                                                                        \
  {                                                                                            \
    _Pragma("unroll") for (int mi = 0; mi < 4; ++mi) {                                         \
      acc[mi][0] = MFMA(FA[mi], FB[0], acc[mi][0]);                                            \
      acc[mi][1] = MFMA(FA[mi], FB[1], acc[mi][1]);                                            \
    }                                                                                          \
  }
#define H_ITER(STC, DOW, STW, DOL, KTL)                                                        \
  {                                                                                            \
    const char* as_ = smem + (STC) * 73728 + (wm * 128 + r) * 144 + h * 16;                    \
    const char* bs_ = smem + (STC) * 73728 + 36864 + (wn * 64 + r) * 144 + h * 16;             \
    char* ws_ = smem + (STW) * 73728 + crow * 144 + kc * 16;                                   \
    bf16x8 fa[4], fb[2][2];                                                                    \
    fb[0][0] = *(const bf16x8*)(bs_);                                                          \
    fb[0][1] = *(const bf16x8*)(bs_ + 32 * 144);                                               \
    _Pragma("unroll") for (int mi = 0; mi < 4; ++mi) fa[mi] = *(const bf16x8*)(as_ + mi * 32 * 144); \
    _Pragma("unroll") for (int ks = 0; ks < 4; ++ks) {                                         \
      if (ks < 3) {                                                                            \
        fb[(ks + 1) & 1][0] = *(const bf16x8*)(bs_ + (ks + 1) * 32);                           \
        fb[(ks + 1) & 1][1] = *(const bf16x8*)(bs_ + 32 * 144 + (ks + 1) * 32);                \
      }                                                                                        \
      _Pragma("unroll") for (int mi = 0; mi < 4; ++mi) {                                       \
        acc[mi][0] = MFMA(fa[mi], fb[ks & 1][0], acc[mi][0]);                                  \
        acc[mi][1] = MFMA(fa[mi], fb[ks & 1][1], acc[mi][1]);                                  \
        if (ks < 3) fa[mi] = *(const bf16x8*)(as_ + mi * 32 * 144 + (ks + 1) * 32);            \
      }                                                                                        \
      if (ks == 0 && (DOW)) {                                                                  \
        __builtin_amdgcn_sched_barrier(0);                                                     \
        _Pragma("unroll") for (int i = 0; i < 4; ++i) *(u32x4*)(ws_ + i * 64 * 144) = ra[i];   \
        __builtin_amdgcn_sched_barrier(0);                                                     \
        if (DOL) H_LOADA(KTL)                                                                  \
      }                                                                                        \
      if (ks == 1 && (DOW)) {                                                                  \
        __builtin_amdgcn_sched_barrier(0);                                                     \
        _Pragma("unroll") for (int i = 0; i < 4; ++i) *(u32x4*)(ws_ + 36864 + i * 64 * 144) = rb[i]; \
        __builtin_amdgcn_sched_barrier(0);                                                     \
      }                                                                                        \
      if (ks == 1 && (DOL)) H_LOADB(KTL)                                                       \
    }                                                                                          \
  }
  H_LOAD(0)
  H_WRITE(0)
  H_LOAD(1)
  __syncthreads();
  for (int kt = 0; kt + 2 < nk; kt += 2) {
    H_ITER(0, 1, 1, 1, kt + 2)
    __syncthreads();
    H_ITER(1, 1, 0, 1, kt + 3)
    __syncthreads();
  }
  H_ITER(0, 1, 1, 0, 0)
  __syncthreads();
  H_ITER(1, 0, 0, 0, 0)
  __syncthreads();
}

DI void zero_acc8(f32x16 (&acc)[4][2]) {
#pragma unroll
  for (int i = 0; i < 4; ++i)
#pragma unroll
    for (int j = 0; j < 2; ++j)
#pragma unroll
      for (int e = 0; e < 16; ++e) acc[i][j][e] = 0.f;
}
#define EPI256_BEGIN                                                                   \
  {                                                                                    \
    const int t8_ = TID8, lane_ = t8_ & 63, wave_ = t8_ >> 6;                          \
    const int wm_ = wave_ >> 2, wn_ = wave_ & 3, rr_ = lane_ & 31, hh_ = lane_ >> 5;   \
    _Pragma("unroll") for (int mi = 0; mi < 4; ++mi)                                   \
    _Pragma("unroll") for (int ni = 0; ni < 2; ++ni)                                   \
    _Pragma("unroll") for (int reg = 0; reg < 16; ++reg) {                             \
      const int row = wm_ * 128 + mi * 32 + (reg & 3) + 8 * (reg >> 2) + 4 * hh_;      \
      const int col = wn_ * 64 + ni * 32 + rr_;                                        \
      const float v = acc[mi][ni][reg];
#define EPI256_END }}

DI void tile256(int t, int& rt, int& ct) { const int x = t & 7, j = t >> 3; rt = x * 8 + (j >> 2); ct = j & 3; }

DI bool rasterV(int it, int NRT, int NCT, int& rt, int& ct, int xrot = 0) {
  const int per = VG >> 3;
  const int ord = (it * 8 + (int)((blockIdx.x + xrot) & 7)) * per + (int)(blockIdx.x >> 3) * 2 + HB;
  const int sr = ord / (8 * NCT), rem = ord - sr * 8 * NCT;
  ct = rem >> 3;
  rt = sr * 8 + (rem & 7);
  return rt < NRT;
}
DI int rasterV_iters(int NRT, int NCT) { return (((NRT + 7) >> 3) * 8 * NCT + VG - 1) / VG; }

DI void zero_acc(f32x16 (&acc)[2][2]) {
#pragma unroll
  for (int i = 0; i < 2; ++i)
#pragma unroll
    for (int j = 0; j < 2; ++j)
#pragma unroll
      for (int e = 0; e < 16; ++e) acc[i][j][e] = 0.f;
}

#define EPI_BEGIN                                                                      \
  {                                                                                    \
    const int lane_ = TIDX & 63, wave_ = TIDX >> 6;                      \
    const int wm_ = wave_ >> 1, wn_ = wave_ & 1, rr_ = lane_ & 31, hh_ = lane_ >> 5;   \
    _Pragma("unroll") for (int mi = 0; mi < 2; ++mi)                                   \
    _Pragma("unroll") for (int ni = 0; ni < 2; ++ni)                                   \
    _Pragma("unroll") for (int reg = 0; reg < 16; ++reg) {                             \
      const int row = wm_ * 64 + mi * 32 + (reg & 3) + 8 * (reg >> 2) + 4 * hh_;       \
      const int col = wn_ * 64 + ni * 32 + rr_;                                        \
      const float v = acc[mi][ni][reg];
#define EPI_END }}

DI f32x16 small_gemm32(const u16* __restrict__ A, size_t lda, const u16* __restrict__ Bt, size_t ldb, int K, char* smem) {
  const int tid = TIDX, lane = tid & 63, wave = tid >> 6, r = lane & 31, h = lane >> 5;
  const int kw = K >> 2;
  const u16* pa = A + (size_t)r * lda + wave * kw + 8 * h;
  const u16* pb = Bt + (size_t)r * ldb + wave * kw + 8 * h;
  f32x16 c;
#pragma unroll
  for (int e = 0; e < 16; ++e) c[e] = 0.f;
#pragma unroll 4
  for (int ks = 0; ks < (kw >> 4); ++ks) {
    const bf16x8 a = *(const bf16x8*)(pa + 16 * ks);
    const bf16x8 b = *(const bf16x8*)(pb + 16 * ks);
    c = MFMA(a, b, c);
  }
  float* red = (float*)smem;
#pragma unroll
  for (int e = 0; e < 16; ++e) red[(wave * 16 + e) * 64 + lane] = c[e];
  __syncthreads();
  f32x16 o;
#pragma unroll
  for (int e = 0; e < 16; ++e) o[e] = red[e * 64 + lane] + red[(16 + e) * 64 + lane] + red[(32 + e) * 64 + lane] + red[(48 + e) * 64 + lane];
  __syncthreads();
  return o;
}
DI f32x16 small_gemm32w8(const u16* __restrict__ A, size_t lda, const u16* __restrict__ Bt, size_t ldb, int K, char* smem) {
  const int tid = TID8, lane = tid & 63, wave = tid >> 6, r = lane & 31, h = lane >> 5;
  const int kw = K >> 3;
  const u16* pa = A + (size_t)r * lda + wave * kw + 8 * h;
  const u16* pb = Bt + (size_t)r * ldb + wave * kw + 8 * h;
  f32x16 c;
#pragma unroll
  for (int e = 0; e < 16; ++e) c[e] = 0.f;
#pragma unroll 4
  for (int ks = 0; ks < (kw >> 4); ++ks) {
    const bf16x8 a = *(const bf16x8*)(pa + 16 * ks);
    const bf16x8 b = *(const bf16x8*)(pb + 16 * ks);
    c = MFMA(a, b, c);
  }
  float* red = (float*)smem;
#pragma unroll
  for (int e = 0; e < 16; ++e) red[(wave * 16 + e) * 64 + lane] = c[e];
  __syncthreads();
  f32x16 o;
#pragma unroll
  for (int e = 0; e < 16; ++e) o[e] = 0.f;
#pragma unroll 1
  for (int w8 = 0; w8 < 8; ++w8) {
#pragma unroll
    for (int e = 0; e < 16; ++e) o[e] += red[(w8 * 16 + e) * 64 + lane];
  }
  __syncthreads();
  return o;
}
#define SMALL8_EPI_BEGIN(C)                                                            \
  if ((TID8 >> 6) == 0) {                                                              \
    const int lane_ = TID8 & 63, rr_ = lane_ & 31, hh_ = lane_ >> 5;                   \
    _Pragma("unroll") for (int reg = 0; reg < 16; ++reg) {                             \
      const int row = (reg & 3) + 8 * (reg >> 2) + 4 * hh_;                            \
      const int col = rr_;                                                             \
      const float v = (C)[reg];
#define SMALL_EPI_BEGIN(C)                                                             \
  if ((TIDX >> 6) == 0) {                                                              \
    const int lane_ = TIDX & 63, rr_ = lane_ & 31, hh_ = lane_ >> 5;                   \
    _Pragma("unroll") for (int reg = 0; reg < 16; ++reg) {                             \
      const int row = (reg & 3) + 8 * (reg >> 2) + 4 * hh_;                            \
      const int col = rr_;                                                             \
      const float v = (C)[reg];
#define SMALL_EPI_END }}

struct TJob { const float* src; u16* dst; int K, N, k0, n0; };
DI void tt_load(const TJob& j, f32x4 (&v)[4]) {
  const int tid = TIDX;
#pragma unroll
  for (int i = 0; i < 4; ++i) {
    const int c = tid + 256 * i, kk = c >> 4, n = j.n0 + (c & 15) * 4;
    const int nc = n < j.N ? n : 0;
    v[i] = __builtin_nontemporal_load((const f32x4*)(j.src + (size_t)(j.k0 + kk) * j.N + nc));
    if (n >= j.N) v[i] = (f32x4){0.f, 0.f, 0.f, 0.f};
  }
}
DI void tt_store(const TJob& j, const f32x4 (&v)[4], float* s, bool ok) {
  const int tid = TIDX;
#pragma unroll
  for (int i = 0; i < 4; ++i) {
    const int c = tid + 256 * i, kk = c >> 4, n4 = (c & 15) * 4;
    s[kk * 65 + n4] = v[i][0]; s[kk * 65 + n4 + 1] = v[i][1]; s[kk * 65 + n4 + 2] = v[i][2]; s[kk * 65 + n4 + 3] = v[i][3];
  }
  __syncthreads();
  const int nn = tid >> 2, kq = (tid & 3) * 16;
#pragma unroll
  for (int q = 0; q < 2; ++q) {
    u32x4 o;
#pragma unroll
    for (int e = 0; e < 4; ++e) o[e] = pk2(s[(kq + 8 * q + 2 * e) * 65 + nn], s[(kq + 8 * q + 2 * e + 1) * 65 + nn]);
    if (ok) *(u32x4*)(j.dst + (size_t)(j.n0 + nn) * j.K + j.k0 + kq + 8 * q) = o;
  }
  __syncthreads();
}

DI void cvt_range(const float* __restrict__ src, u16* __restrict__ dst, size_t n4, size_t gt, size_t gs) {
#pragma unroll 8
  for (size_t i = gt; i < n4; i += gs) {
    const float4 v = ((const float4*)src)[i];
    uint2 o; o.x = pk2(v.x, v.y); o.y = pk2(v.z, v.w);
    ((uint2*)dst)[i] = o;
  }
}

DI void phase0(const Params& p, char* smem_) {
  char* ws = p.ws;
  char* smem = smem_ + HB * HALF_BYTES;
  {
    auto decode = [&](int t) {
      TJob j;
      int K, N, NT, base; const float* src; size_t off;
      if (t < 288)       { src = p.in[8];  off = W_WINT;   K = 1024; N = 1056; base = 0; }
      else if (t < 336)  { src = p.in[10]; off = W_WQBT;   K = 256;  N = 768;  base = 288; }
      else if (t < 400)  { src = p.in[12]; off = W_WKVBT;  K = 256;  N = 1024; base = 336; }
      else if (t < 416)  { src = p.in[13]; off = W_WPOOLT; K = 512;  N = 128;  base = 400; }
      else if (t < 672)  { src = p.in[15]; off = W_WOT;    K = 1024; N = 1024; base = 416; }
      else if (t < 2080) { src = p.in[18]; off = W_WUPT;   K = 1024; N = 5632; base = 672; }
      else if (t < 2784) { src = p.in[21]; off = W_WDOWNT; K = 2816; N = 1024; base = 2080; }
      else if (t < 3040) { src = p.in[22]; off = W_WPGT;   K = 1024; N = 1024; base = 2784; }
      else               { src = p.in[23]; off = W_WPET;   K = 256;  N = 1024; base = 3040; }
      (void)NT;
      const int KT = K >> 6, tt = t - base;
      j.src = src; j.dst = (u16*)(ws + off); j.K = K; j.N = N; j.k0 = (tt % KT) * 64; j.n0 = (tt / KT) * 64;
      return j;
    };
    constexpr size_t C0 = (size_t)TP * 1024 / 4, C1 = C0 + (size_t)TS * 1024 / 4, C2 = C1 + (size_t)TP * 256 / 4,
                     C3 = C2 + (size_t)TS * 256 / 4, C4 = C3 + (size_t)256 * 768 / 4, CT = C4 + (size_t)256 * 1024 / 4;
    auto cdec = [&](size_t idx, const f32x4*& src, uint2*& dst) {
      if (idx < C0)      { src = (const f32x4*)p.in[0] + idx;         dst = (uint2*)(ws + W_XB) + idx; }
      else if (idx < C1) { src = (const f32x4*)p.in[1] + (idx - C0);  dst = (uint2*)(ws + W_XB) + idx; }
      else if (idx < C2) { src = (const f32x4*)p.in[6] + (idx - C1);  dst = (uint2*)(ws + W_PEB) + (idx - C1); }
      else if (idx < C3) { src = (const f32x4*)p.in[7] + (idx - C2);  dst = (uint2*)(ws + W_PEB) + (idx - C1); }
      else if (idx < C4) { src = (const f32x4*)p.in[10] + (idx - C3); dst = (uint2*)(ws + W_WQB) + (idx - C3); }
      else               { src = (const f32x4*)p.in[12] + (idx - C4); dst = (uint2*)(ws + W_WKVB) + (idx - C4); }
    };
    const size_t gtc = (size_t)VB * 256 + TIDX, nthr = (size_t)VG * 256;
    const int NTILE = 3104, nIt = (NTILE + VG - 1) / VG;
    int t = VB;
    bool ok = t < NTILE;
    TJob cur = decode(ok ? t : 0);
    f32x4 v[4];
    tt_load(cur, v);
    for (int i = 0; i < nIt; ++i) {
      f32x4 cv[6];
      uint2* cd[6];
      bool cok[6];
#pragma unroll
      for (int u = 0; u < 6; ++u) {
        const size_t idx = (size_t)(i * 6 + u) * nthr + gtc;
        cok[u] = idx < CT;
        const f32x4* src;
        cdec(cok[u] ? idx : CT - 1, src, cd[u]);
        cv[u] = __builtin_nontemporal_load(src);
      }
      const int tn = t + VG;
      const bool okn = tn < NTILE;
      const TJob nxt = decode(okn ? tn : 0);
      f32x4 vn[4];
      tt_load(nxt, vn);
      tt_store(cur, v, (float*)smem, ok);
      cur = nxt; ok = okn; t = tn;
#pragma unroll
      for (int q = 0; q < 4; ++q) v[q] = vn[q];
#pragma unroll
      for (int u = 0; u < 6; ++u)
        if (cok[u]) { uint2 o; o.x = pk2(cv[u][0], cv[u][1]); o.y = pk2(cv[u][2], cv[u][3]); *cd[u] = o; }
    }
    for (size_t idx = (size_t)nIt * 6 * nthr + gtc; idx < CT; idx += nthr) {
      const f32x4* src; uint2* dst;
      cdec(idx, src, dst);
      const f32x4 c = *src;
      uint2 o; o.x = pk2(c[0], c[1]); o.y = pk2(c[2], c[3]);
      *dst = o;
    }
  }
  const size_t gt = (size_t)VB * 256 + TIDX, gs = (size_t)VG * 256;
  float2* rope = (float2*)(ws + W_ROPE);
  for (size_t i = gt; i < (size_t)16384 * 16; i += gs) {
    const int pos = (int)(i >> 4), k = (int)(i & 15);
    const float inv = 1.0f / powf(10000.0f, (float)(2 * k) / 32.0f);
    const float ang = (float)pos * inv;
    const double ad = (double)ang;
    const double nrev = rint(ad * 0.15915494309189535);
    const float red = (float)(ad - nrev * 6.283185307179586);
    rope[i] = make_float2(__cosf(red), __sinf(red));
  }
  if (gt < 64) ((int*)(ws + W_CNT))[gt] = 0;
}

DI void phase1(const Params& p, char* smem) {
  char* ws = p.ws;
  char* hs = smem + HB * HALF_BYTES;
  float* z = (float*)(ws + W_Z);
  for (int t = blockIdx.x; t < 256; t += gridDim.x) {
    int rt, ct;
    tile256(t, rt, ct);
    f32x16 acc[4][2];
    zero_acc8(acc);
    const u16* A = (const u16*)(ws + W_XB) + (size_t)rt * 256 * 1024;
    const u16* B = (const u16*)(ws + W_WINT) + (size_t)ct * 256 * 1024;
    gemm256(A, 1024, 0, 256, B, B + 128 * 1024, 1024, 1024, acc, smem);
    EPI256_BEGIN
      z[(size_t)(rt * 256 + row) * INW + ct * 256 + col] = v;
    EPI256_END
  }
  for (int q = blockIdx.x; q < 520 + 256; q += gridDim.x) {
    int r0, c0;
    if (q < 520) { r0 = q * 32; c0 = 1024; } else { r0 = TP + ((q - 520) >> 5) * 32; c0 = ((q - 520) & 31) * 32; }
    const f32x16 c = small_gemm32w8((const u16*)(ws + W_XB) + (size_t)r0 * 1024, 1024, (const u16*)(ws + W_WINT) + (size_t)c0 * 1024, 1024, 1024, smem);
    SMALL8_EPI_BEGIN(c)
      z[(size_t)(r0 + row) * INW + c0 + col] = v;
    SMALL_EPI_END
  }
  for (int q0 = blockIdx.x * 2; q0 < 32; q0 += VG) {
    const int q = q0 + HB;
    f32x16 acc[2][2];
    zero_acc(acc);
    const int hd = q >> 2, lt = (q >> 1) & 1, kt = q & 1;
    const u16* A = (const u16*)(ws + W_WKVB) + (size_t)(lt * 128) * 1024 + hd * 128;
    const u16* B = (const u16*)(ws + W_WQB) + (size_t)(kt * 128) * 768 + hd * 96;
    gemm_main(A, 1024, 0, 128, B, B + 64 * 768, 768, 64, acc, hs);
    u16* o = (u16*)(ws + W_WQLT);
    EPI_BEGIN
      o[(size_t)(hd * 256 + lt * 128 + row) * 256 + kt * 128 + col] = bf1(v);
    EPI_END
  }
}

DI void phase2(const Params& p) {
  char* ws = p.ws;
  const float* z = (const float*)(ws + W_Z);
  const float2* rope = (const float2*)(ws + W_ROPE);
  const int lane = TIDX & 63;
  const int gw = VB * 4 + (TIDX >> 6), nw = VG * 4;
  const float4 gq = ((const float4*)p.in[9])[lane];
  const float4 gkv = ((const float4*)p.in[11])[lane];
  for (int row = gw; row < TT; row += nw) {
    const float* zr = z + (size_t)row * INW;
    const bool samp = row >= TP;
    const int srow = row - TP, sb = srow >> 4, st = srow & 15;
    const float4 ld_q = nt_ld4((const float4*)zr + lane);
    const float4 ld_c = nt_ld4((const float4*)(zr + 256) + lane);
    const float ld_x1 = zr[512 + (lane & 15)], ld_x2 = zr[528 + (lane & 15)];
    const float4 ld_u0 = ((const float4*)(zr + 544 + lane * 8))[0], ld_u1 = ((const float4*)(zr + 544 + lane * 8))[1];
    const float2 ld_cs = rope[(samp ? 4096 + st : row) * 16 + (lane & 15)];
    {
      const float4 v = ld_q;
      const float ss = wave_sum(v.x * v.x + v.y * v.y + v.z * v.z + v.w * v.w);
      const float rs = rsqrtf(ss * (1.0f / 256.0f) + 1e-6f);
      uint2 o; o.x = pk2(v.x * rs * gq.x, v.y * rs * gq.y); o.y = pk2(v.z * rs * gq.z, v.w * rs * gq.w);
      ((uint2*)((u16*)(ws + W_QN) + (size_t)row * 256))[lane] = o;
    }
    {
      const float4 v = ld_c;
      const float ss = wave_sum(v.x * v.x + v.y * v.y + v.z * v.z + v.w * v.w);
      const float rs = rsqrtf(ss * (1.0f / 256.0f) + 1e-6f);
      float4 c; c.x = v.x * rs * gkv.x; c.y = v.y * rs * gkv.y; c.z = v.z * rs * gkv.z; c.w = v.w * rs * gkv.w;
      float* co = samp ? p.out + O_CKVS + (size_t)srow * 256 : p.out + O_CKVP + (size_t)row * 256;
      ((float4*)co)[lane] = c;
      uint2 o; o.x = pk2(c.x, c.y); o.y = pk2(c.z, c.w);
      ((uint2*)((u16*)(ws + W_CB) + (size_t)row * 256))[lane] = o;
    }
    if (lane < 16) {
      const float x1 = ld_x1, x2 = ld_x2;
      const float2 cs = ld_cs;
      const float o1 = x1 * cs.x - x2 * cs.y, o2 = x2 * cs.x + x1 * cs.y;
      float* ko = samp ? p.out + O_KRS + (size_t)srow * 32 : p.out + O_KRP + (size_t)row * 32;
      ko[lane] = o1; ko[16 + lane] = o2;
      if (!samp) {
        u16* kr = (u16*)(ws + W_KRB) + (size_t)row * 32;
        kr[lane] = bf1(o1); kr[16 + lane] = bf1(o2);
      }
    }
    {
      const float* ur = zr + 544 + lane * 8;
      const float4 u0 = ld_u0, u1 = ld_u1;
      float* po = nullptr;
      if (!samp) { if (row >= TP - 15) po = p.out + O_POOLP + (size_t)(row - (TP - 15)) * 512; }
      else if (st >= 1) po = p.out + O_POOLS + ((size_t)sb * 15 + (st - 1)) * 512;
      if (po) { ((float4*)(po + lane * 8))[0] = u0; ((float4*)(po + lane * 8))[1] = u1; }
      if (samp) {
        const int g = lane >> 4, w = 2 << g;
        float4 s0 = u0, s1 = u1;
        for (int i = 1; i < 16; ++i) {
          if (i < w) {
            const float* src = (st - i >= 0) ? ur - (size_t)i * INW : p.in[4] + ((size_t)sb * 15 + (15 + st - i)) * 512 + lane * 8;
            const float4 a = ((const float4*)src)[0], b = ((const float4*)src)[1];
            s0.x += a.x; s0.y += a.y; s0.z += a.z; s0.w += a.w;
            s1.x += b.x; s1.y += b.y; s1.z += b.z; s1.w += b.w;
          }
        }
        const float ic = 1.0f / (float)w;
        uint4 o;
        o.x = pk2(s0.x * ic - u0.x, s0.y * ic - u0.y); o.y = pk2(s0.z * ic - u0.z, s0.w * ic - u0.w);
        o.z = pk2(s1.x * ic - u1.x, s1.y * ic - u1.y); o.w = pk2(s1.z * ic - u1.z, s1.w * ic - u1.w);
        ((uint4*)((u16*)(ws + W_DB) + (size_t)row * 512))[lane] = o;
      }
    }
  }
  for (int task = gw; task < (TP / 32) * 4; task += nw) {
    const int g = task & 3, j0 = (task >> 2) * 32, W = 2 << g;
    const int col = 128 * g + 2 * lane;
    const float* up = z + 544 + col;
    u16* db = (u16*)(ws + W_DB) + col;
    float sx = 0.f, sy = 0.f;
#pragma unroll 4
    for (int i = 1; i <= 16; ++i) {
      const int jj = j0 - i;
      const float2 t = *(const float2*)(up + (size_t)(jj >= 0 ? jj : 0) * INW);
      const bool ok = (i <= W) && (jj >= 0);
      sx += ok ? t.x : 0.f; sy += ok ? t.y : 0.f;
    }
#pragma unroll 8
    for (int j = j0; j < j0 + 32; ++j) {
      const float2 v = *(const float2*)(up + (size_t)j * INW);
      const int jo = j - W;
      const float2 o = *(const float2*)(up + (size_t)(jo >= 0 ? jo : 0) * INW);
      sx += v.x - (jo >= 0 ? o.x : 0.f);
      sy += v.y - (jo >= 0 ? o.y : 0.f);
      const int cnt = j + 1 < W ? j + 1 : W;
      const float ic = __builtin_amdgcn_rcpf((float)cnt);
      *(unsigned*)(db + (size_t)j * 512) = pk2(sx * ic - v.x, sy * ic - v.y);
    }
  }
}

DI void phase3(const Params& p, char* smem_) {
  char* ws = p.ws;
  char* smem = smem_ + HB * HALF_BYTES;
  const float2* rope = (const float2*)(ws + W_ROPE);
  for (int it = 0, nIt = rasterV_iters(130, 6); it < nIt; ++it) {
    int rt, ct;
    const bool ok = rasterV(it, 130, 6, rt, ct);
    if (!ok) { rt = 0; ct = 0; }
    f32x16 acc[2][2];
    zero_acc(acc);
    {
      const u16* A = (const u16*)(ws + W_QN) + (size_t)rt * 128 * 256;
      const u16* B = (const u16*)(ws + W_WQBT) + (size_t)ct * 128 * 256;
      gemm_main(A, 256, 0, 128, B, B + 64 * 256, 256, 256, acc, smem);
      if (!ok) continue;
      u16* qb = (u16*)(ws + W_QBUF);
      EPI_BEGIN
        const int cg_ = ct * 128 + col, rg_ = rt * 128 + row;
        float o = v * QSCALE;
        const bool is_rope = (((cg_ >> 5) % 3) == 2);
        if (is_rope) {
          const int pos = rg_ < TP ? rg_ : 4096 + ((rg_ - TP) & 15);
          const float2 cs = rope[pos * 16 + (rr_ & 15)];
          const float pr = __shfl_xor(o, 16);
          o = (rr_ < 16) ? o * cs.x - pr * cs.y : o * cs.x + pr * cs.y;
        }
        qb[(size_t)rg_ * 768 + cg_] = bf1(o);
      EPI_END
    }
  }
  for (int it = 0, nIt = rasterV_iters(128, 8); it < nIt; ++it) {
    int rt, hd;
    const bool ok = rasterV(it, 128, 8, rt, hd);
    if (!ok) { rt = 0; hd = 0; }
    f32x16 acc[2][2];
    zero_acc(acc);
    {
      const u16* A = (const u16*)(ws + W_CB) + (size_t)rt * 128 * 256;
      const u16* B = (const u16*)(ws + W_WKVBT) + (size_t)hd * 128 * 256;
      if (ok) {
        const u16* krb = (const u16*)(ws + W_KRB) + (size_t)rt * 128 * 32;
        u16* kg2 = (u16*)(ws + W_KG) + ((size_t)hd * TP + rt * 128) * 96 + 64;
#pragma unroll 2
        for (int i = 0; i < 8; ++i) {
          const int idx = TIDX + 256 * i, rw = idx >> 4, cp = idx & 15;
          *(unsigned*)(kg2 + (size_t)rw * 96 + cp * 2) = *(const unsigned*)(krb + rw * 32 + cp * 2);
        }
      }
      gemm_main(A, 256, 0, 128, B, B + 64 * 256, 256, 256, acc, smem);
      if (!ok) continue;
      const int lane = TIDX & 63, wave = TIDX >> 6, wm = wave >> 1, wn = wave & 1, r = lane & 31, h = lane >> 5;
      if (wn == 0) {
        u16* kg = (u16*)(ws + W_KG) + (size_t)hd * TP * 96;
#pragma unroll
        for (int mi = 0; mi < 2; ++mi)
#pragma unroll
          for (int ni = 0; ni < 2; ++ni)
#pragma unroll
            for (int reg = 0; reg < 16; ++reg) {
              const int row = rt * 128 + wm * 64 + mi * 32 + (reg & 3) + 8 * (reg >> 2) + 4 * h;
              kg[(size_t)row * 96 + ni * 32 + r] = bf1(acc[mi][ni][reg]);
            }
      } else {
        u16* vt = (u16*)(ws + W_VT) + (size_t)hd * 64 * TP;
#pragma unroll
        for (int mi = 0; mi < 2; ++mi)
#pragma unroll
          for (int ni = 0; ni < 2; ++ni)
#pragma unroll
            for (int g = 0; g < 4; ++g) {
              const int dv = ni * 32 + r;
              const int pos = rt * 128 + wm * 64 + mi * 32 + 16 * (g >> 1) + 8 * h + 4 * (g & 1);
              uint2 o;
              o.x = pk2(acc[mi][ni][4 * g], acc[mi][ni][4 * g + 1]);
              o.y = pk2(acc[mi][ni][4 * g + 2], acc[mi][ni][4 * g + 3]);
              *(uint2*)(vt + (size_t)dv * TP + pos) = o;
            }
      }
    }
  }
  const int qlx = (int)(blockIdx.x & 7) - 6, qlj = (int)(blockIdx.x >> 3) * 2 + qlx;
  const bool ql_spread = gridDim.x >= 64;
  for (int q0 = ql_spread ? ((qlx >= 0 && qlj < 16) ? 2 * qlj : 32) : (int)blockIdx.x * 2; q0 < 32; q0 += ql_spread ? 32 : VG) {
    f32x16 acc[2][2];
    zero_acc(acc);
    {
      const int q = q0 + HB;
      const int rt = q >> 4, ct = q & 15;
      const u16* A = (const u16*)(ws + W_QN) + (size_t)(TP + rt * 128) * 256;
      const u16* B = (const u16*)(ws + W_WQLT) + (size_t)ct * 128 * 256;
      gemm_main(A, 256, 0, 128, B, B + 64 * 256, 256, 256, acc, smem);
      u16* ql = (u16*)(ws + W_QLAT);
      EPI_BEGIN
        ql[(size_t)(rt * 128 + row) * 2048 + ct * 128 + col] = bf1(v * QSCALE);
      EPI_END
    }
  }
  for (int it = 0, nIt = rasterV_iters(130, 4); it < nIt; ++it) {
    int rt, g;
    const bool ok = rasterV(it, 130, 4, rt, g, 3);
    if (!ok) { rt = 0; g = 0; }
    f32x16 acc[2][2];
    zero_acc(acc);
    {
      const u16* A = (const u16*)(ws + W_DB) + (size_t)rt * 128 * 512 + g * 128;
      const u16* B = (const u16*)(ws + W_WPOOLT) + g * 128;
      gemm_main(A, 512, 0, 128, B, B + 64 * 512, 512, 128, acc, smem);
      if (!ok) continue;
      u16* ob = (u16*)(ws + W_OBUF);
      const float* sp = p.in[14];
      EPI_BEGIN
        ob[(size_t)(rt * 128 + row) * 1024 + 512 + g * 128 + col] = bf1(v * sp[g * 128 + col]);
      EPI_END
    }
  }
}

DI bf16x8 pack8(const f32x16& x, int s) {
  uint4 u;
  u.x = pk2(x[8 * s + 0], x[8 * s + 1]); u.y = pk2(x[8 * s + 2], x[8 * s + 3]);
  u.z = pk2(x[8 * s + 4], x[8 * s + 5]); u.w = pk2(x[8 * s + 6], x[8 * s + 7]);
  return __builtin_bit_cast(bf16x8, u);
}

template <int NW>
DI void attn_prompt_item(const Params& p, int qb, int hd, char* smem, int tid) {
  constexpr int NT = 64 * NW, KPT = (768 + NT - 1) / NT, VPT = 512 / NT, CH = NW / 2;
  char* ws = p.ws;
  const int lane = tid & 63, w = tid >> 6, r = lane & 31, h = lane >> 5;
  const u16* qbuf = (const u16*)(ws + W_QBUF);
  const char* Kh = (const char*)((const u16*)(ws + W_KG) + (size_t)hd * TP * 96);
  const u16* Vh = (const u16*)(ws + W_VT) + (size_t)hd * 64 * TP;
  bf16x8 qf[6];
  const size_t qrow = (size_t)qb * (32 * NW) + w * 32 + r;
#pragma unroll
  for (int ks = 0; ks < 6; ++ks) qf[ks] = *(const bf16x8*)(qbuf + qrow * 768 + hd * 96 + ks * 16 + h * 8);
  f32x16 o0, o1, o2;
#pragma unroll
  for (int e = 0; e < 16; ++e) { o0[e] = 0.f; o1[e] = 0.f; o2[e] = 0.f; }
  float m = 0.f;
  f32x16 nm;
#pragma unroll
  for (int e = 0; e < 16; ++e) nm[e] = 0.f;
  bf16x8 ones;
#pragma unroll
  for (int e = 0; e < 8; ++e) ones[e] = (short)0x3F80;
  const int nt = CH * qb + CH, my_nt = CH * qb + 1 + (w >> 1);
  u32x4 rk[KPT], rv[VPT];
#define PA_LOAD(T)                                                                             \
  {                                                                                            \
    const int t_ = (T);                                                                        \
    _Pragma("unroll") for (int i = 0; i < KPT; ++i) {                                          \
      const int c = tid + NT * i, cc = c < 768 ? c : c - 768;                                  \
      rk[i] = *(const u32x4*)(Kh + (size_t)t_ * 64 * 192 + (size_t)cc * 16);                   \
    }                                                                                          \
    _Pragma("unroll") for (int i = 0; i < VPT; ++i) {                                          \
      const int c = tid + NT * i;                                                              \
      rv[i] = *(const u32x4*)(Vh + (size_t)(c >> 3) * TP + t_ * 64 + (c & 7) * 8);             \
    }                                                                                          \
    __builtin_amdgcn_sched_barrier(0);                                                         \
  }
#define PA_WRITE(B)                                                                            \
  {                                                                                            \
    char* kb_ = smem + (B) * 22528;                                                            \
    __builtin_amdgcn_sched_barrier(0);                                                         \
    _Pragma("unroll") for (int i = 0; i < KPT; ++i) {                                          \
      const int c = tid + NT * i;                                                              \
      char* d_ = c < 768 ? kb_ + (c / 12) * 208 + (c % 12) * 16 : smem + 45056 + (c - 768) * 16; \
      *(u32x4*)d_ = rk[i];                                                                     \
    }                                                                                          \
    _Pragma("unroll") for (int i = 0; i < VPT; ++i) {                                          \
      const int c = tid + NT * i;                                                              \
      *(u32x4*)(kb_ + 13312 + (c >> 3) * 144 + (c & 7) * 16) = rv[i];                          \
    }                                                                                          \
    __builtin_amdgcn_sched_barrier(0);                                                         \
  }
  PA_LOAD(0)
  PA_WRITE(0)
  PA_LOAD((1 < nt ? 1 : nt - 1))
  __syncthreads();
  for (int kt = 0; kt < nt; ++kt) {
    const int cur = kt & 1;
    PA_WRITE(cur ^ 1)
    PA_LOAD((kt + 2 < nt ? kt + 2 : nt - 1))
    if (kt < my_nt) {
      const char* Ks = smem + cur * 22528;
      const char* Vs = Ks + 13312;
      f32x16 s0, s1;
      bf16x8 kf0[6], kf1[6];
#pragma unroll
      for (int ks = 0; ks < 6; ++ks) {
        kf0[ks] = *(const bf16x8*)(Ks + r * 208 + ks * 32 + h * 16);
        kf1[ks] = *(const bf16x8*)(Ks + (32 + r) * 208 + ks * 32 + h * 16);
      }
      __builtin_amdgcn_sched_barrier(0);
      s0 = MFMA(kf0[0], qf[0], nm);
      s1 = MFMA(kf1[0], qf[0], nm);
#pragma unroll
      for (int ks = 1; ks < 6; ++ks) {
        s0 = MFMA(kf0[ks], qf[ks], s0);
        s1 = MFMA(kf1[ks], qf[ks], s1);
      }
      bf16x8 vf0[4], vf1[4];
#pragma unroll
      for (int s = 0; s < 4; ++s) {
        vf0[s] = *(const bf16x8*)(Vs + r * 144 + s * 32 + h * 16);
        vf1[s] = *(const bf16x8*)(Vs + (32 + r) * 144 + s * 32 + h * 16);
      }
      __builtin_amdgcn_sched_barrier(0);
      float mx = s0[0];
#pragma unroll
      for (int e = 1; e < 16; ++e) mx = fmaxf(mx, s0[e]);
#pragma unroll
      for (int e = 0; e < 16; ++e) mx = fmaxf(mx, s1[e]);
      mx = half_max(mx);
      if (kt == 0 || __builtin_amdgcn_ballot_w64(mx > 0.f) != 0ull) {
        const float dl = (kt == 0) ? mx : fmaxf(mx, 0.f);
        const float al_ = (kt == 0) ? 1.0f : fexp2(-dl);
        m += dl;
#pragma unroll
        for (int e = 0; e < 16; ++e) { o0[e] *= al_; o1[e] *= al_; s0[e] -= dl; s1[e] -= dl; nm[e] = -m; }
        o2[0] *= al_;
      }
#pragma unroll
      for (int e = 0; e < 16; ++e) s0[e] = fexp2(s0[e]);
#pragma unroll
      for (int e = 0; e < 16; ++e) s1[e] = fexp2(s1[e]);
      bf16x8 pf[4];
      pf[0] = pack8(s0, 0); pf[1] = pack8(s0, 1); pf[2] = pack8(s1, 0); pf[3] = pack8(s1, 1);
#pragma unroll
      for (int s = 0; s < 4; ++s) {
        o0 = MFMA(vf0[s], pf[s], o0);
        o1 = MFMA(vf1[s], pf[s], o1);
        o2 = MFMA(ones, pf[s], o2);
      }
    }
    __syncthreads();
  }
  const float il = __builtin_amdgcn_rcpf(o2[0]);
  u16* ob = (u16*)(ws + W_OBUF) + qrow * 1024 + hd * 64;
#pragma unroll
  for (int g = 0; g < 4; ++g) {
    uint2 a, b;
    a.x = pk2(o0[4 * g] * il, o0[4 * g + 1] * il); a.y = pk2(o0[4 * g + 2] * il, o0[4 * g + 3] * il);
    b.x = pk2(o1[4 * g] * il, o1[4 * g + 1] * il); b.y = pk2(o1[4 * g + 2] * il, o1[4 * g + 3] * il);
    *(uint2*)(ob + 8 * g + 4 * h) = a;
    *(uint2*)(ob + 32 + 8 * g + 4 * h) = b;
  }
}

DI void attn_prompt_item128(const Params& p, int qb, int hd, char* smem, int tid) {
  char* ws = p.ws;
  const int lane = tid & 63, w = tid >> 6, r = lane & 31, h = lane >> 5;
  const u16* qbuf = (const u16*)(ws + W_QBUF);
  const char* Kh = (const char*)((const u16*)(ws + W_KG) + (size_t)hd * TP * 96);
  const u16* Vh = (const u16*)(ws + W_VT) + (size_t)hd * 64 * TP;
  bf16x8 qf[6];
  const size_t qrow = (size_t)qb * 256 + w * 32 + r;
#pragma unroll
  for (int ks = 0; ks < 6; ++ks) qf[ks] = *(const bf16x8*)(qbuf + qrow * 768 + hd * 96 + ks * 16 + h * 8);
  f32x16 o0, o1, o2;
#pragma unroll
  for (int e = 0; e < 16; ++e) { o0[e] = 0.f; o1[e] = 0.f; o2[e] = 0.f; }
  float m = 0.f;
  f32x16 nm;
#pragma unroll
  for (int e = 0; e < 16; ++e) nm[e] = 0.f;
  bf16x8 ones;
#pragma unroll
  for (int e = 0; e < 8; ++e) ones[e] = (short)0x3F80;
  const int nt = 2 * qb + 2, my_n64 = 4 * qb + 1 + (w >> 1);
  u32x4 rk[3], rv[2];
#define PB_LOAD(T)                                                                             \
  {                                                                                            \
    const int t_ = (T);                                                                        \
    _Pragma("unroll") for (int i = 0; i < 3; ++i)                                              \
      rk[i] = *(const u32x4*)(Kh + (size_t)t_ * 128 * 192 + (size_t)(tid + 512 * i) * 16);     \
    _Pragma("unroll") for (int i = 0; i < 2; ++i) {                                            \
      const int c = tid + 512 * i;                                                             \
      rv[i] = *(const u32x4*)(Vh + (size_t)(c >> 4) * TP + t_ * 128 + (c & 15) * 8);           \
    }                                                                                          \
    __builtin_amdgcn_sched_barrier(0);                                                         \
  }
#define PB_WRITE(B)                                                                            \
  {                                                                                            \
    char* kb_ = smem + (B) * 44032;                                                            \
    __builtin_amdgcn_sched_barrier(0);                                                         \
    _Pragma("unroll") for (int i = 0; i < 3; ++i) {                                            \
      const int c = tid + 512 * i;                                                             \
      *(u32x4*)(kb_ + (c / 12) * 208 + (c % 12) * 16) = rk[i];                                 \
    }                                                                                          \
    _Pragma("unroll") for (int i = 0; i < 2; ++i) {                                            \
      const int c = tid + 512 * i;                                                             \
      *(u32x4*)(kb_ + 26624 + (c >> 4) * 272 + (c & 15) * 16) = rv[i];                         \
    }                                                                                          \
    __builtin_amdgcn_sched_barrier(0);                                                         \
  }
#define PB_STEP(KS_, VS_, FIRST)                                                               \
  {                                                                                            \
    const char* Ks = (KS_);                                                                    \
    const char* Vs = (VS_);                                                                    \
    f32x16 s0, s1;                                                                             \
    bf16x8 kf0[6], kf1[6];                                                                     \
    _Pragma("unroll") for (int ks = 0; ks < 6; ++ks) {                                         \
      kf0[ks] = *(const bf16x8*)(Ks + r * 208 + ks * 32 + h * 16);                             \
      kf1[ks] = *(const bf16x8*)(Ks + (32 + r) * 208 + ks * 32 + h * 16);                      \
    }                                                                                          \
    __builtin_amdgcn_sched_barrier(0);                                                         \
    s0 = MFMA(kf0[0], qf[0], nm);                                                              \
    s1 = MFMA(kf1[0], qf[0], nm);                                                              \
    _Pragma("unroll") for (int ks = 1; ks < 6; ++ks) {                                         \
      s0 = MFMA(kf0[ks], qf[ks], s0);                                                          \
      s1 = MFMA(kf1[ks], qf[ks], s1);                                                          \
    }                                                                                          \
    bf16x8 vf0[4], vf1[4];                                                                     \
    _Pragma("unroll") for (int s = 0; s < 4; ++s) {                                            \
      vf0[s] = *(const bf16x8*)(Vs + r * 272 + s * 32 + h * 16);                               \
      vf1[s] = *(const bf16x8*)(Vs + (32 + r) * 272 + s * 32 + h * 16);                        \
    }                                                                                          \
    __builtin_amdgcn_sched_barrier(0);                                                         \
    float mx = s0[0];                                                                          \
    _Pragma("unroll") for (int e = 1; e < 16; ++e) mx = fmaxf(mx, s0[e]);                      \
    _Pragma("unroll") for (int e = 0; e < 16; ++e) mx = fmaxf(mx, s1[e]);                      \
    mx = half_max(mx);                                                                         \
    if ((FIRST) || __builtin_amdgcn_ballot_w64(mx > 0.f) != 0ull) {                            \
      const float dl = (FIRST) ? mx : fmaxf(mx, 0.f);                                          \
      const float al_ = (FIRST) ? 1.0f : fexp2(-dl);                                           \
      m += dl;                                                                                 \
      _Pragma("unroll") for (int e = 0; e < 16; ++e) { o0[e] *= al_; o1[e] *= al_; s0[e] -= dl; s1[e] -= dl; nm[e] = -m; } \
      o2[0] *= al_;                                                                            \
    }                                                                                          \
    _Pragma("unroll") for (int e = 0; e < 16; ++e) s0[e] = fexp2(s0[e]);                       \
    _Pragma("unroll") for (int e = 0; e < 16; ++e) s1[e] = fexp2(s1[e]);                       \
    bf16x8 pf[4];                                                                              \
    pf[0] = pack8(s0, 0); pf[1] = pack8(s0, 1); pf[2] = pack8(s1, 0); pf[3] = pack8(s1, 1);    \
    _Pragma("unroll") for (int s = 0; s < 4; ++s) {                                            \
      o0 = MFMA(vf0[s], pf[s], o0);                                                            \
      o1 = MFMA(vf1[s], pf[s], o1);                                                            \
      o2 = MFMA(ones, pf[s], o2);                                                              \
    }                                                                                          \
  }
  PB_LOAD(0)
  PB_WRITE(0)
  PB_LOAD((1 < nt ? 1 : nt - 1))
  __syncthreads();
  for (int kt = 0; kt < nt; ++kt) {
    const int cur = kt & 1;
    PB_WRITE(cur ^ 1)
    PB_LOAD((kt + 2 < nt ? kt + 2 : nt - 1))
    const char* kb = smem + cur * 44032;
    if (2 * kt < my_n64) PB_STEP(kb, kb + 26624, (kt == 0))
    if (2 * kt + 1 < my_n64) PB_STEP(kb + 64 * 208, kb + 26624 + 128, false)
    __syncthreads();
  }
  const float il = __builtin_amdgcn_rcpf(o2[0]);
  u16* ob = (u16*)(ws + W_OBUF) + qrow * 1024 + hd * 64;
#pragma unroll
  for (int g = 0; g < 4; ++g) {
    uint2 a, b;
    a.x = pk2(o0[4 * g] * il, o0[4 * g + 1] * il); a.y = pk2(o0[4 * g + 2] * il, o0[4 * g + 3] * il);
    b.x = pk2(o1[4 * g] * il, o1[4 * g + 1] * il); b.y = pk2(o1[4 * g + 2] * il, o1[4 * g + 3] * il);
    *(uint2*)(ob + 8 * g + 4 * h) = a;
    *(uint2*)(ob + 32 + 8 * g + 4 * h) = b;
  }
}

DI void attn_sample_item(const Params& p, int b, int hh, int sp, char* smem) {
  char* ws = p.ws;
  const int tid = TIDX, lane = tid & 63, w = tid >> 6, r = lane & 31, h = lane >> 5;
  const int rgp = w & 1, dvh = w >> 1;
  char* Qs = smem + 32 * 592;
  __syncthreads();
  for (int c = tid; c < 64 * 36; c += 256) {
    const int rw = c / 36, part = c % 36;
    const int hq = 4 * hh + (rw >> 4);
    const size_t sr_ = (size_t)b * 16 + (rw & 15);
    const u16* src = part < 32 ? (const u16*)(ws + W_QLAT) + sr_ * 2048 + hq * 256 + part * 8
                               : (const u16*)(ws + W_QBUF) + ((size_t)TP + sr_) * 768 + hq * 96 + 64 + (part - 32) * 8;
    *(uint4*)(Qs + rw * 592 + part * 16) = *(const uint4*)src;
  }
  f32x16 o[4];
#pragma unroll
  for (int i = 0; i < 4; ++i)
#pragma unroll
    for (int e = 0; e < 16; ++e) o[i][e] = 0.f;
  float m = -1e30f, l = 0.f;
  const int t0 = 33 * sp, t1 = (33 * sp + 33 < 129) ? 33 * sp + 33 : 129;
  const float* cc = p.in[2] + (size_t)b * 4096 * 256;
  const float* ck = p.in[3] + (size_t)b * 4096 * 32;
  const float* nc = p.out + O_CKVS + (size_t)b * 16 * 256;
  const float* nk = p.out + O_KRS + (size_t)b * 16 * 32;
  char* Ks = smem;
  f32x4 rc[8], rr;
#define SAMPLE_LOAD_TILE(KT)                                                                   \
  {                                                                                            \
    _Pragma("unroll") for (int i = 0; i < 8; ++i) {                                            \
      const int c = tid + 256 * i, key = c >> 6, part = c & 63, gk = (KT) * 32 + key;          \
      if (gk < 4096) rc[i] = __builtin_nontemporal_load((const f32x4*)(cc + (size_t)gk * 256) + part);                \
      else if (gk < 4112) rc[i] = ((const f32x4*)(nc + (size_t)(gk - 4096) * 256))[part];     \
      else rc[i] = (f32x4){0.f, 0.f, 0.f, 0.f};                                            \
    }                                                                                          \
    {                                                                                          \
      const int key = tid >> 3, part = tid & 7, gk = (KT) * 32 + key;                          \
      if (gk < 4096) rr = __builtin_nontemporal_load((const f32x4*)(ck + (size_t)gk * 32) + part);                   \
      else if (gk < 4112) rr = ((const f32x4*)(nk + (size_t)(gk - 4096) * 32))[part];         \
      else rr = (f32x4){0.f, 0.f, 0.f, 0.f};                                               \
    }                                                                                          \
  }
  SAMPLE_LOAD_TILE(t0)
  const int i16 = lane & 15, tq_ = i16 >> 2, tp_ = i16 & 3, blk = (lane >> 4) & 1;
  for (int kt = t0; kt < t1; ++kt) {
    __syncthreads();
#pragma unroll
    for (int i = 0; i < 8; ++i) {
      const int c = tid + 256 * i, key = c >> 6, part = c & 63;
      uint2 u; u.x = pk2(rc[i].x, rc[i].y); u.y = pk2(rc[i].z, rc[i].w);
      *(uint2*)(Ks + key * 592 + part * 8) = u;
    }
    {
      const int key = tid >> 3, part = tid & 7;
      uint2 u; u.x = pk2(rr.x, rr.y); u.y = pk2(rr.z, rr.w);
      *(uint2*)(Ks + key * 592 + 512 + part * 8) = u;
    }
    __syncthreads();
    if (kt + 1 < t1) SAMPLE_LOAD_TILE(kt + 1)
    f32x16 s;
#pragma unroll
    for (int e = 0; e < 16; ++e) s[e] = 0.f;
#pragma unroll
    for (int ks = 0; ks < 18; ++ks) {
      const bf16x8 kf = *(const bf16x8*)(Ks + r * 592 + ks * 32 + h * 16);
      const bf16x8 qv = *(const bf16x8*)(Qs + (32 * rgp + r) * 592 + ks * 32 + h * 16);
      s = MFMA(kf, qv, s);
    }
    const int kbase = kt * 32 + 4 * h;
#pragma unroll
    for (int e = 0; e < 16; ++e) {
      const int gk = kbase + (e & 3) + 8 * (e >> 2);
      if (gk >= 4112) s[e] = -1e30f;
    }
    float mx = s[0];
#pragma unroll
    for (int e = 1; e < 16; ++e) mx = fmaxf(mx, s[e]);
    mx = half_max(mx);
    const float mn = fmaxf(m, mx);
    const float al_ = fexp2(m - mn);
    m = mn;
    float ls = 0.f;
#pragma unroll
    for (int e = 0; e < 16; ++e) { s[e] = fexp2(s[e] - mn); ls += s[e]; }
    l = l * al_ + ls;
#pragma unroll
    for (int i = 0; i < 4; ++i)
#pragma unroll
      for (int e = 0; e < 16; ++e) o[i][e] *= al_;
    bf16x8 pf[2];
    pf[0] = pack8(s, 0); pf[1] = pack8(s, 1);
#pragma unroll
    for (int nd = 0; nd < 4; ++nd) {
      const int dv0 = 128 * dvh + 32 * nd;
#pragma unroll
      for (int s2 = 0; s2 < 2; ++s2) {
        const char* a0 = Ks + (16 * s2 + 4 * h + tq_) * 592 + (dv0 + 16 * blk) * 2 + 8 * tp_;
        const s16x4 lo = __builtin_amdgcn_ds_read_tr16_b64_v4i16(LDS3(s16x4, a0));
        const s16x4 hi = __builtin_amdgcn_ds_read_tr16_b64_v4i16(LDS3(s16x4, a0 + 8 * 592));
        const bf16x8 vf = __builtin_shufflevector(lo, hi, 0, 1, 2, 3, 4, 5, 6, 7);
        o[nd] = MFMA(vf, pf[s2], o[nd]);
      }
    }
  }
  l = half_sum(l);
  const int row128 = (4 * hh + 2 * rgp) * 16 + r;
  const size_t pbase = ((size_t)(b * NSP + sp) * 128 + row128);
  float* op = (float*)(ws + W_OPART) + pbase * 256;
#pragma unroll
  for (int nd = 0; nd < 4; ++nd)
#pragma unroll
    for (int g = 0; g < 4; ++g) {
      float4 v; v.x = o[nd][4 * g]; v.y = o[nd][4 * g + 1]; v.z = o[nd][4 * g + 2]; v.w = o[nd][4 * g + 3];
      *(float4*)(op + 128 * dvh + 32 * nd + 8 * g + 4 * h) = v;
    }
  if (dvh == 0 && h == 0) {
    float* ml = (float*)(ws + W_ML) + pbase * 2;
    ml[0] = m; ml[1] = l;
  }
  __syncthreads();
}

DI void combine_batch(const Params& p, char* smem, int bsel) {
  char* ws = p.ws;
  float* sl = (float*)smem;
  float* sr = (float*)smem + 4096;
  const int tid = TIDX;
  const float* wkv = p.in[12];
  const float* ml = (const float*)(ws + W_ML);
  const float* op = (const float*)(ws + W_OPART);
  for (int i0 = 0; i0 < 8; i0 += 2) {
    const int hd = i0 + HB;
#pragma unroll 4
    for (int tq = 0; tq < 16; ++tq) {
      const int row128 = hd * 16 + tq;
      float ms[NSP], ls[NSP], M = -1e30f;
#pragma unroll
      for (int s2 = 0; s2 < NSP; ++s2) {
        const size_t pb = ((size_t)(bsel * NSP + s2) * 128 + row128);
        ms[s2] = ml[pb * 2]; ls[s2] = ml[pb * 2 + 1];
        M = fmaxf(M, ms[s2]);
      }
      float L = 0.f, a = 0.f;
#pragma unroll
      for (int s2 = 0; s2 < NSP; ++s2) {
        const size_t pb = ((size_t)(bsel * NSP + s2) * 128 + row128);
        const float wgt = fexp2(ms[s2] - M);
        L += wgt * ls[s2];
        a += wgt * op[pb * 256 + tid];
      }
      sl[tq * 256 + tid] = a * __builtin_amdgcn_rcpf(L);
    }
    __syncthreads();
    const int vv = tid & 63, part = tid >> 6;
    float acc[16];
#pragma unroll
    for (int tq = 0; tq < 16; ++tq) acc[tq] = 0.f;
#pragma unroll 4
    for (int i = 0; i < 64; ++i) {
      const int li = part * 64 + i;
      const float wv = wkv[(size_t)li * 1024 + hd * 128 + 64 + vv];
#pragma unroll
      for (int tq = 0; tq < 16; ++tq) acc[tq] += wv * sl[tq * 256 + li];
    }
#pragma unroll
    for (int tq = 0; tq < 16; ++tq) sr[(part * 16 + tq) * 64 + vv] = acc[tq];
    __syncthreads();
#pragma unroll
    for (int k = 0; k < 4; ++k) {
      const int o = tid + 256 * k, tq = o >> 6, v = o & 63;
      const float r4 = sr[(0 * 16 + tq) * 64 + v] + sr[(1 * 16 + tq) * 64 + v] + sr[(2 * 16 + tq) * 64 + v] + sr[(3 * 16 + tq) * 64 + v];
      ((u16*)(ws + W_OBUF))[((size_t)TP + bsel * 16 + tq) * 1024 + hd * 64 + v] = bf1(r4);
    }
    __syncthreads();
  }
}

DI void phase4(const Params& p, char* smem, int* s_item) {
  char* hs = smem + HB * HALF_BYTES;
  int* cnt = (int*)(p.ws + W_CNT);
  const int NSI = 16 * NSP, NITEM = NSI + 512;
  for (;;) {
    if (threadIdx.x == 0) *s_item = atomicAdd(cnt, 1);
    __syncthreads();
    const int it = *s_item;
    __syncthreads();
    if (it >= NITEM) break;
    if (it < NSI) {
      const int bsel = it / NSP;
      attn_sample_item(p, bsel, HB, it % NSP, hs);
      asm volatile("s_waitcnt vmcnt(0)" ::: "memory");
      __syncthreads();
      if (threadIdx.x == 0) {
        __builtin_amdgcn_fence(__ATOMIC_RELEASE, "agent");
        asm volatile("s_waitcnt vmcnt(0)" ::: "memory");
        const int old = __hip_atomic_fetch_add(cnt + 16 + bsel, 1, __ATOMIC_RELAXED, __HIP_MEMORY_SCOPE_AGENT);
        const int last = (old == NSP - 1) ? 1 : 0;
        if (last) {
          __builtin_amdgcn_fence(__ATOMIC_ACQUIRE, "agent");
          asm volatile("s_waitcnt vmcnt(0)" ::: "memory");
        }
        *s_item = last;
      }
      __syncthreads();
      const int last = *s_item;
      __syncthreads();
      if (last) combine_batch(p, hs, bsel);
    } else {
      const int q = it - NSI;
      attn_prompt_item128(p, 63 - (q >> 3), q & 7, smem, TID8);
    }
  }
}

DI void phase5(const Params& p, char* smem) {
  char* ws = p.ws;
  char* hs = smem + HB * HALF_BYTES;
  for (int t = blockIdx.x; t < 256; t += gridDim.x) {
    int rt, ct;
    tile256(t, rt, ct);
    f32x16 acc[4][2];
    zero_acc8(acc);
    const u16* A = (const u16*)(ws + W_OBUF) + (size_t)rt * 256 * 1024;
    const u16* B = (const u16*)(ws + W_WOT) + (size_t)ct * 256 * 1024;
    gemm256(A, 1024, 0, 256, B, B + 128 * 1024, 1024, 1024, acc, smem);
    const float* xs = p.in[0] + (size_t)rt * 256 * 1024;
    float* y = p.out + O_Y + (size_t)rt * 256 * 1024;
    {
      const int t8 = TID8, lane = t8 & 63, wave = t8 >> 6, wm = wave >> 2, wn = wave & 3, r = lane & 31, h = lane >> 5;
      const size_t off = (size_t)(wm * 128 + 4 * h) * 1024 + ct * 256 + wn * 64 + r;
      const float* __restrict__ xs_ = xs + off;
      float* __restrict__ y_ = y + off;
#pragma unroll
      for (int mi = 0; mi < 4; ++mi)
#pragma unroll
        for (int ni = 0; ni < 2; ++ni) {
          float xv[16];
#pragma unroll
          for (int reg = 0; reg < 16; ++reg) xv[reg] = __builtin_nontemporal_load(&xs_[(size_t)(mi * 32 + (reg & 3) + 8 * (reg >> 2)) * 1024 + ni * 32]);
#pragma unroll
          for (int reg = 0; reg < 16; ++reg) y_[(size_t)(mi * 32 + (reg & 3) + 8 * (reg >> 2)) * 1024 + ni * 32] = ALPHA_F * xv[reg] + acc[mi][ni][reg];
        }
    }
  }
  for (int q = blockIdx.x; q < 256; q += gridDim.x) {
    const int r0 = (q >> 5) * 32, c0 = (q & 31) * 32;
    const f32x16 c = small_gemm32w8((const u16*)(ws + W_OBUF) + (size_t)(TP + r0) * 1024, 1024, (const u16*)(ws + W_WOT) + (size_t)c0 * 1024, 1024, 1024, smem);
    const float* xs = p.in[1];
    float* y = p.out + O_Y + (size_t)TP * 1024;
    if ((TID8 >> 6) == 0) {
      const int lane = TID8 & 63, rr = lane & 31, hh = lane >> 5;
      float xv[16];
#pragma unroll
      for (int reg = 0; reg < 16; ++reg) xv[reg] = __builtin_nontemporal_load(&xs[(size_t)(r0 + (reg & 3) + 8 * (reg >> 2) + 4 * hh) * 1024 + c0 + rr]);
#pragma unroll
      for (int reg = 0; reg < 16; ++reg) y[(size_t)(r0 + (reg & 3) + 8 * (reg >> 2) + 4 * hh) * 1024 + c0 + rr] = ALPHA_F * xv[reg] + c[reg];
    }
  }
}

DI void phase_ln(const Params& p, const float* __restrict__ g, const float* __restrict__ bta, u16* bcopy) {
  const int lane = TIDX & 63;
  const int gw = VB * 4 + (TIDX >> 6), nw = VG * 4;
  float4 gg[4], bb[4];
#pragma unroll
  for (int i = 0; i < 4; ++i) { gg[i] = ((const float4*)g)[lane + 64 * i]; bb[i] = ((const float4*)bta)[lane + 64 * i]; }
  for (int row = gw; row < TT; row += nw) {
    float4* y = (float4*)(p.out + O_Y + (size_t)row * 1024);
    float4 v[4];
    float s = 0.f;
#pragma unroll
    for (int i = 0; i < 4; ++i) { v[i] = nt_ld4(y + lane + 64 * i); s += v[i].x + v[i].y + v[i].z + v[i].w; }
    const float mu = wave_sum(s) * (1.0f / 1024.0f);
    float q = 0.f;
#pragma unroll
    for (int i = 0; i < 4; ++i) {
      v[i].x -= mu; v[i].y -= mu; v[i].z -= mu; v[i].w -= mu;
      q += v[i].x * v[i].x + v[i].y * v[i].y + v[i].z * v[i].z + v[i].w * v[i].w;
    }
    const float rs = rsqrtf(wave_sum(q) * (1.0f / 1024.0f) + 1e-5f);
#pragma unroll
    for (int i = 0; i < 4; ++i) {
      float4 o;
      o.x = v[i].x * rs * gg[i].x + bb[i].x; o.y = v[i].y * rs * gg[i].y + bb[i].y;
      o.z = v[i].z * rs * gg[i].z + bb[i].z; o.w = v[i].w * rs * gg[i].w + bb[i].w;
      if (!bcopy) nt_st4(y + lane + 64 * i, o);
      if (bcopy) {
        uint2 u; u.x = pk2(o.x, o.y); u.y = pk2(o.z, o.w);
        ((uint2*)(bcopy + (size_t)row * 1024))[lane + 64 * i] = u;
      }
    }
  }
}

DI void phase7(const Params& p, char* smem) {
  char* ws = p.ws;
  char* hs = smem + HB * HALF_BYTES;
  const float* wdw = p.in[19];
  const float* bdw = p.in[20];
  const float* hist = p.in[5];
  for (int it = 0;; ++it) {
    const int b = blockIdx.x, per = gridDim.x >> 3;
    const int ord = (it * 8 + (b & 7)) * per + (b >> 3);
    if (ord >= 66 * 22) break;
    int ri, jt;
    if (ord < 64 * 22) { const int sr = ord / 176, rem = ord - sr * 176; jt = rem >> 3; ri = sr * 8 + (rem & 7); }
    else { const int o = ord - 64 * 22; ri = 64 + (o & 1); jt = o >> 1; }
    f32x16 acc[4][2];
    zero_acc8(acc);
    const bool samp = ri == 65;
    const int r0 = samp ? TP : 254 * ri - 2;
    int rlo = 0, rhi = 256;
    if (!samp) { if (r0 < 0) rlo = -r0; if (r0 + 256 > TP) rhi = TP - r0; }
    const int j0 = jt * 128;
    const u16* A = (const u16*)(ws + W_X1B) + (ptrdiff_t)r0 * 1024;
    const u16* B0 = (const u16*)(ws + W_WUPT) + (size_t)j0 * 1024;
    const u16* B1 = (const u16*)(ws + W_WUPT) + (size_t)(DFF + j0) * 1024;
    gemm256<true>(A, 1024, rlo, rhi, B0, B1, 1024, 1024, acc, smem);
    {
      const int t8 = TID8, lane = t8 & 63, wave = t8 >> 6, wm = wave >> 2, wn = wave & 3, r = lane & 31, h = lane >> 5;
      const int jp = t8 & 63, rgp = t8 >> 6;
      const int ca_ = j0 + 2 * jp, cb_ = DFF + j0 + 2 * jp;
      const float2 w0a = *(const float2*)(wdw + ca_), w1a = *(const float2*)(wdw + DFF2 + ca_), w2a = *(const float2*)(wdw + 2 * DFF2 + ca_), ba = *(const float2*)(bdw + ca_);
      const float2 w0b = *(const float2*)(wdw + cb_), w1b = *(const float2*)(wdw + DFF2 + cb_), w2b = *(const float2*)(wdw + 2 * DFF2 + cb_), bb2 = *(const float2*)(bdw + cb_);
      u16* act = (u16*)(ws + W_ACT);
#pragma unroll
      for (int c = 0; c < 4; ++c) {
        float* Uc = (float*)(smem + (c & 1) * 67584);
        const float* Up = (const float*)(smem + ((c & 1) ^ 1) * 67584);
        if (wm == (c >> 1)) {
#pragma unroll
          for (int mm = 0; mm < 2; ++mm)
#pragma unroll
            for (int ni = 0; ni < 2; ++ni)
#pragma unroll
              for (int reg = 0; reg < 16; ++reg)
                Uc[(mm * 32 + (reg & 3) + 8 * (reg >> 2) + 4 * h) * 264 + wn * 64 + ni * 32 + r] = acc[2 * (c & 1) + mm][ni][reg];
        }
        __syncthreads();
        {
          const int lr0 = rgp * 8, trow0 = 64 * c + lr0;
          int lbeg = lr0;
          const float* Ua = Uc + 2 * jp;
          float2 u0a, u0b, u1a, u1b;
          if (samp && (trow0 & 15) == 0) {
            const float* hb = hist + (size_t)(trow0 >> 4) * 2 * DFF2;
            u0a = *(const float2*)(hb + ca_); u0b = *(const float2*)(hb + cb_);
            u1a = *(const float2*)(hb + DFF2 + ca_); u1b = *(const float2*)(hb + DFF2 + cb_);
          } else if (lr0 == 0) {
            if (c == 0) {
              lbeg = 2;
              u0a = *(const float2*)(Ua); u0b = *(const float2*)(Ua + 128);
              u1a = *(const float2*)(Ua + 264); u1b = *(const float2*)(Ua + 264 + 128);
            } else {
              u0a = *(const float2*)(Up + 62 * 264 + 2 * jp); u0b = *(const float2*)(Up + 62 * 264 + 2 * jp + 128);
              u1a = *(const float2*)(Up + 63 * 264 + 2 * jp); u1b = *(const float2*)(Up + 63 * 264 + 2 * jp + 128);
            }
          } else {
            u0a = *(const float2*)(Ua + (lr0 - 2) * 264); u0b = *(const float2*)(Ua + (lr0 - 2) * 264 + 128);
            u1a = *(const float2*)(Ua + (lr0 - 1) * 264); u1b = *(const float2*)(Ua + (lr0 - 1) * 264 + 128);
          }
          for (int lr = lbeg; lr < lr0 + 8; ++lr) {
            const int trow = 64 * c + lr, grow = r0 + trow;
            const float2 u2a = *(const float2*)(Ua + lr * 264), u2b = *(const float2*)(Ua + lr * 264 + 128);
            if (samp || grow < TP) {
              const float cax = w0a.x * u0a.x + w1a.x * u1a.x + w2a.x * u2a.x + ba.x;
              const float cay = w0a.y * u0a.y + w1a.y * u1a.y + w2a.y * u2a.y + ba.y;
              const float cbx = w0b.x * u0b.x + w1b.x * u1b.x + w2b.x * u2b.x + bb2.x;
              const float cby = w0b.y * u0b.y + w1b.y * u1b.y + w2b.y * u2b.y + bb2.y;
              const float sx = cax * __builtin_amdgcn_rcpf(1.0f + __expf(-cax));
              const float sy = cay * __builtin_amdgcn_rcpf(1.0f + __expf(-cay));
              *(unsigned*)(act + (size_t)grow * DFF + ca_) = pk2(sx * cbx, sy * cby);
              const bool st_p = !samp && grow >= TP - 2;
              const bool st_s = samp && (trow & 15) >= 14;
              if (st_p || st_s) {
                float* cp = st_p ? p.out + O_CONVP + (size_t)(grow - (TP - 2)) * DFF2
                                 : p.out + O_CONVS + ((size_t)(trow >> 4) * 2 + ((trow & 15) - 14)) * DFF2;
                *(float2*)(cp + ca_) = u2a; *(float2*)(cp + cb_) = u2b;
              }
            }
            u0a = u1a; u0b = u1b; u1a = u2a; u1b = u2b;
          }
        }
        __syncthreads();
      }
    }
  }
  const int lrk = 32 * (int)(blockIdx.x & 7) + (int)(blockIdx.x >> 3) - 172;
  const bool lgt = gridDim.x == 256;
  for (int q = lgt ? (lrk >= 0 ? lrk : 256) : (int)blockIdx.x; q < 256; q += lgt ? 84 : (int)gridDim.x) {
    const int r0 = (q >> 5) * 32, c0 = (q & 31) * 32;
    const f32x16 g = small_gemm32w8((const u16*)(ws + W_X1B) + (size_t)(TP + r0) * 1024, 1024, (const u16*)(ws + W_WPGT) + (size_t)c0 * 1024, 1024, 1024, smem);
    const f32x16 e = small_gemm32w8((const u16*)(ws + W_PEB) + (size_t)(TP + r0) * 256, 256, (const u16*)(ws + W_WPET) + (size_t)c0 * 256, 256, 256, smem);
    u16* ple = (u16*)(ws + W_PLE) + (size_t)TP * 1024;
    SMALL8_EPI_BEGIN(e)
      ple[(size_t)(r0 + row) * 1024 + c0 + col] = bf1(v * __builtin_amdgcn_rcpf(1.0f + __expf(-g[reg])));
    SMALL_EPI_END
  }
  for (int t = blockIdx.x; t < 256; t += gridDim.x) {
    int rt, ct;
    tile256(t, rt, ct);
    f32x16 acc[4][2];
    zero_acc8(acc);
    u16* ple = (u16*)(ws + W_PLE) + (size_t)rt * 256 * 1024 + ct * 256;
    const u16* A2 = (const u16*)(ws + W_X1B) + (size_t)rt * 256 * 1024;
    const u16* Bg = (const u16*)(ws + W_WPGT) + (size_t)ct * 256 * 1024;
    gemm256(A2, 1024, 0, 256, Bg, Bg + 128 * 1024, 1024, 1024, acc, smem);
    EPI256_BEGIN
      ple[(size_t)row * 1024 + col] = bf1(__builtin_amdgcn_rcpf(1.0f + __expf(-v)));
    EPI256_END
    zero_acc8(acc);
    const u16* A1 = (const u16*)(ws + W_PEB) + (size_t)rt * 256 * 256;
    const u16* Bp = (const u16*)(ws + W_WPET) + (size_t)ct * 256 * 256;
    gemm256(A1, 256, 0, 256, Bp, Bp + 128 * 256, 256, 256, acc, smem);
    {
      const int t8 = TID8, lane = t8 & 63, wave = t8 >> 6, wm = wave >> 2, wn = wave & 3, r = lane & 31, h = lane >> 5;
      u16* pp = ple + (size_t)(wm * 128 + 4 * h) * 1024 + wn * 64 + r;
#pragma unroll
      for (int mi = 0; mi < 4; ++mi)
#pragma unroll
        for (int ni = 0; ni < 2; ++ni) {
          float gv[16];
#pragma unroll
          for (int reg = 0; reg < 16; ++reg) gv[reg] = bf2f(pp[(size_t)(mi * 32 + (reg & 3) + 8 * (reg >> 2)) * 1024 + ni * 32]);
#pragma unroll
          for (int reg = 0; reg < 16; ++reg) pp[(size_t)(mi * 32 + (reg & 3) + 8 * (reg >> 2)) * 1024 + ni * 32] = bf1(acc[mi][ni][reg] * gv[reg]);
        }
    }
  }
}

DI void phase9(const Params& p, char* smem) {
  char* ws = p.ws;
  char* hs = smem + HB * HALF_BYTES;
  for (int t = blockIdx.x; t < 256; t += gridDim.x) {
    int rt, ct;
    tile256(t, rt, ct);
    f32x16 acc[4][2];
    zero_acc8(acc);
    const u16* A = (const u16*)(ws + W_ACT) + (size_t)rt * 256 * DFF;
    const u16* B = (const u16*)(ws + W_WDOWNT) + (size_t)ct * 256 * DFF;
    gemm256(A, DFF, 0, 256, B, B + 128 * DFF, DFF, DFF, acc, smem);
    float* y = p.out + O_Y + (size_t)rt * 256 * 1024;
    const u16* ple = (const u16*)(ws + W_PLE) + (size_t)rt * 256 * 1024;
    {
      const int t8 = TID8, lane = t8 & 63, wave = t8 >> 6, wm = wave >> 2, wn = wave & 3, r = lane & 31, h = lane >> 5;
      const size_t off = (size_t)(wm * 128 + 4 * h) * 1024 + ct * 256 + wn * 64 + r;
      float* __restrict__ y_ = y + off;
      const u16* __restrict__ pl_ = ple + off;
      const u16* __restrict__ x1_ = (const u16*)(ws + W_X1B) + (size_t)rt * 256 * 1024 + off;
#pragma unroll
      for (int mi = 0; mi < 4; ++mi)
#pragma unroll
        for (int ni = 0; ni < 2; ++ni) {
          float yv[16], pv[16];
#pragma unroll
          for (int reg = 0; reg < 16; ++reg) {
            const size_t o = (size_t)(mi * 32 + (reg & 3) + 8 * (reg >> 2)) * 1024 + ni * 32;
            yv[reg] = bf2f(__builtin_nontemporal_load(&x1_[o])); pv[reg] = bf2f(__builtin_nontemporal_load(&pl_[o]));
          }
#pragma unroll
          for (int reg = 0; reg < 16; ++reg) {
            const size_t o = (size_t)(mi * 32 + (reg & 3) + 8 * (reg >> 2)) * 1024 + ni * 32;
            y_[o] = ALPHA_F * yv[reg] + acc[mi][ni][reg] + pv[reg];
          }
        }
    }
  }
  for (int q = blockIdx.x; q < 256; q += gridDim.x) {
    const int r0 = (q >> 5) * 32, c0 = (q & 31) * 32;
    const f32x16 c = small_gemm32w8((const u16*)(ws + W_ACT) + (size_t)(TP + r0) * DFF, DFF, (const u16*)(ws + W_WDOWNT) + (size_t)c0 * DFF, DFF, DFF, smem);
    float* y = p.out + O_Y + (size_t)TP * 1024;
    const u16* ple = (const u16*)(ws + W_PLE) + (size_t)TP * 1024;
    if ((TID8 >> 6) == 0) {
      const int lane = TID8 & 63, rr = lane & 31, hh = lane >> 5;
      float yv[16], pv[16];
#pragma unroll
      for (int reg = 0; reg < 16; ++reg) {
        const size_t o = (size_t)(r0 + (reg & 3) + 8 * (reg >> 2) + 4 * hh) * 1024 + c0 + rr;
        yv[reg] = bf2f(((const u16*)(ws + W_X1B) + (size_t)TP * 1024)[o]); pv[reg] = bf2f(ple[o]);
      }
#pragma unroll
      for (int reg = 0; reg < 16; ++reg) {
        const size_t o = (size_t)(r0 + (reg & 3) + 8 * (reg >> 2) + 4 * hh) * 1024 + c0 + rr;
        y[o] = ALPHA_F * yv[reg] + c[reg] + pv[reg];
      }
    }
  }
}

#define XB_TMO      128
#define XB_XCNT(j)  (256  + 64 * (j))
#define XB_XSUB(j)  (1280 + 64 * (j))
#define XB_XGEN(j)  (2304 + 64 * (j))
#define XB_TOP      3328
#define XB_TOPGEN   3392
#define XCD_BAR_WORDS 3456
#define XB_SPIN_CAP (1u << 20)
#define LAS __attribute__((address_space(3)))
DI unsigned xb_ld(unsigned* p) { return __hip_atomic_load(p, __ATOMIC_RELAXED, __HIP_MEMORY_SCOPE_AGENT); }
DI unsigned xb_add(unsigned* p, unsigned v) { return __hip_atomic_fetch_add(p, v, __ATOMIC_RELAXED, __HIP_MEMORY_SCOPE_AGENT); }
DI unsigned xb_xcc_id() { return (unsigned)__builtin_amdgcn_s_getreg((3 << 11) | 20) & 0xFu; }
#define XB_SPIN(cond, bar) do { unsigned _sp = 0; while (cond) { __builtin_amdgcn_s_sleep(1); \
    if ((++_sp & 255u) == 0u) { if (xb_ld(&(bar)[XB_TMO])) break; if (_sp > XB_SPIN_CAP) { atomicAdd(&(bar)[XB_TMO], 1u); break; } } } } while (0)
struct XcdBarrier { unsigned* bar; unsigned x; volatile LAS unsigned* st; };
DI XcdBarrier xcd_barrier_post(unsigned* bar, volatile LAS unsigned* st) {
  XcdBarrier b; b.bar = bar; b.x = xb_xcc_id(); b.st = st;
  if (threadIdx.x == 0) (void)xb_add(&bar[XB_XCNT(b.x)], 1u);
  return b;
}
DI void xcd_barrier_complete(unsigned* bar, unsigned x, unsigned& nloc, unsigned& nx) {
  const unsigned G = gridDim.x;
  unsigned sum, cnt, mine, sp = 0u;
  for (;;) {
    sum = 0u; cnt = 0u; mine = 0u;
#pragma unroll
    for (unsigned j = 0; j < 16; ++j) { const unsigned c = xb_ld(&bar[XB_XCNT(j)]); sum += c; cnt += (c > 0u) ? 1u : 0u; mine = (j == x) ? c : mine; }
    if (sum == G) break;
    __builtin_amdgcn_s_sleep(1);
    if ((++sp & 255u) == 0u) { if (xb_ld(&bar[XB_TMO])) break; if (sp > XB_SPIN_CAP) { atomicAdd(&bar[XB_TMO], 1u); break; } }
  }
  nloc = mine > 0u ? mine : 1u; nx = cnt > 0u ? cnt : 1u;
}
DI void xcd_barrier(const XcdBarrier& b) {
  asm volatile("s_waitcnt vmcnt(0)" ::: "memory");
  __syncthreads();
  if (threadIdx.x == 0) {
    unsigned* bar = b.bar;
    __builtin_amdgcn_s_waitcnt(0);
    unsigned nloc = b.st[0], nx = b.st[1];
    if (nloc == 0u) { xcd_barrier_complete(bar, b.x, nloc, nx); b.st[0] = nloc; b.st[1] = nx; }
    const unsigned old = xb_add(&bar[XB_XSUB(b.x)], 1u);
    const unsigned gen = old / nloc;
    if (old + 1u == (gen + 1u) * nloc) {
      __builtin_amdgcn_fence(__ATOMIC_RELEASE, "agent");
      asm volatile("s_waitcnt vmcnt(0)" ::: "memory");
      const unsigned og = xb_add(&bar[XB_TOP], 1u);
      const unsigned tg = og / nx;
      if (og + 1u == (tg + 1u) * nx) xb_add(&bar[XB_TOPGEN], 1u);
      else XB_SPIN(xb_ld(&bar[XB_TOPGEN]) == tg, bar);
      __builtin_amdgcn_fence(__ATOMIC_ACQUIRE, "agent");
      xb_add(&bar[XB_XGEN(b.x)], 1u);
      asm volatile("s_waitcnt vmcnt(0)" ::: "memory");
    } else {
      XB_SPIN(xb_ld(&bar[XB_XGEN(b.x)]) == gen, bar);
      __builtin_amdgcn_fence(__ATOMIC_ACQUIRE, "agent");
      asm volatile("s_waitcnt vmcnt(0)" ::: "memory");
    }
  }
  __syncthreads();
}

__global__ void __launch_bounds__(512, 2) fwd_megakernel(Params p) {
  cg::grid_group grid = cg::this_grid();
  __shared__ __attribute__((aligned(16))) char smem[SMEM_BYTES];
  __shared__ int s_item;
  __shared__ uint4 xb_words;
  if (threadIdx.x == 0) xb_words = make_uint4(0u, 0u, 0u, 0u);
  __syncthreads();
  const XcdBarrier xb = xcd_barrier_post((unsigned*)(p.ws + W_BAR), (volatile LAS unsigned*)&xb_words);
  if (p.ws == nullptr) grid.sync();
  phase0(p, smem);
  xcd_barrier(xb);
  phase1(p, smem);
  xcd_barrier(xb);
  phase2(p);
  xcd_barrier(xb);
  phase3(p, smem);
  xcd_barrier(xb);
  phase4(p, smem, &s_item);
  xcd_barrier(xb);
  phase5(p, smem);
  xcd_barrier(xb);
  phase_ln(p, p.in[16], p.in[17], (u16*)(p.ws + W_X1B));
  xcd_barrier(xb);
  phase7(p, smem);
  xcd_barrier(xb);
  phase9(p, smem);
  xcd_barrier(xb);
  phase_ln(p, p.in[24], p.in[25], nullptr);
}

extern "C" void kernel_launch(void* const* d_in, const int* in_sizes, int n_in, void* d_out, int out_size,
                              void* d_ws, size_t ws_size, hipStream_t stream) {
  static int grid_blocks = 0;
  if (!grid_blocks) {
    int dev = 0, cus = 0, per_cu = 0;
    hipGetDevice(&dev);
    hipDeviceGetAttribute(&cus, hipDeviceAttributeMultiprocessorCount, dev);
    hipOccupancyMaxActiveBlocksPerMultiprocessor(&per_cu, fwd_megakernel, 512, 0);
    if (per_cu > 1) per_cu = 1;
    if (per_cu < 1) per_cu = 1;
    grid_blocks = cus * per_cu;
    if (ws_size < W_TOTAL) fprintf(stderr, "workspace too small: %zu < %zu\n", ws_size, (size_t)W_TOTAL);
  }
  Params p{};
  for (int i = 0; i < 26; ++i) p.in[i] = (const float*)d_in[i];
  p.out = (float*)d_out;
  p.ws = (char*)d_ws;
  (void)hipMemsetAsync((char*)d_ws + W_BAR, 0, 16384, stream);
  void* args[] = {&p};
  hipError_t e = hipLaunchCooperativeKernel((void*)fwd_megakernel, dim3(grid_blocks), dim3(512), args, 0, stream);
  if (e != hipSuccess) fprintf(stderr, "cooperative launch failed: %s (grid %d)\n", hipGetErrorString(e), grid_blocks);
}
```

```cpp
#include <hip/hip_runtime.h>
#include <hip/hip_cooperative_groups.h>
#include <cstdio>
#include <cstdint>
namespace cg = cooperative_groups;

typedef unsigned short u16;
typedef __attribute__((ext_vector_type(8))) short bf16x8;
typedef __attribute__((ext_vector_type(4))) short s16x4;
typedef __attribute__((ext_vector_type(16))) float f32x16;
typedef __attribute__((ext_vector_type(2))) float f32x2;
typedef __attribute__((ext_vector_type(4))) unsigned u32x4;
typedef __attribute__((ext_vector_type(4))) float f32x4;
typedef __attribute__((ext_vector_type(2))) __bf16 bf2_t;
#define DI __device__ __forceinline__
__device__ __forceinline__ int opaque_tid() { int t = threadIdx.x; asm volatile("" : "+v"(t)); return t; }
#define TID8 opaque_tid()
#define TIDX (opaque_tid() & 255)
#define HB (opaque_tid() >> 8)
#define VB ((int)(blockIdx.x * 2 + HB))
#define VG ((int)(gridDim.x * 2))
#define MFMA(a, b, c) __builtin_amdgcn_mfma_f32_32x32x16_bf16((a), (b), (c), 0, 0, 0)
#define LDS3(T, p) ((__attribute__((address_space(3))) T*)(p))

constexpr int TP = 16384, TS = 256, TT = TP + TS;
constexpr int DM = 1024, INW = 1056, DFF = 2816, DFF2 = 5632;
constexpr int NSP = 4;
constexpr float ALPHA_F = 1.189207115002721f;
constexpr float QSCALE = 0.10206207261596577f * 1.4426950408889634f;

constexpr size_t O_Y = 0;
constexpr size_t O_CKVP = (size_t)TT * 1024;
constexpr size_t O_KRP = O_CKVP + (size_t)TP * 256;
constexpr size_t O_POOLP = O_KRP + (size_t)TP * 32;
constexpr size_t O_CONVP = O_POOLP + 15 * 512;
constexpr size_t O_CKVS = O_CONVP + 2 * DFF2;
constexpr size_t O_KRS = O_CKVS + (size_t)TS * 256;
constexpr size_t O_POOLS = O_KRS + (size_t)TS * 32;
constexpr size_t O_CONVS = O_POOLS + 16 * 15 * 512;

constexpr size_t al(size_t x) { return (x + 255) & ~(size_t)255; }
constexpr size_t W_CNT = 0;
constexpr size_t W_ROPE = 4096;
constexpr size_t W_WINT = W_ROPE + (size_t)16384 * 16 * 8;
constexpr size_t W_WQB = W_WINT + (size_t)1152 * 1024 * 2;
constexpr size_t W_WQBT = W_WQB + (size_t)256 * 768 * 2;
constexpr size_t W_WKVB = W_WQBT + (size_t)768 * 256 * 2;
constexpr size_t W_WKVBT = W_WKVB + (size_t)256 * 1024 * 2;
constexpr size_t W_WPOOLT = W_WKVBT + (size_t)1024 * 256 * 2;
constexpr size_t W_WOT = W_WPOOLT + (size_t)128 * 512 * 2;
constexpr size_t W_WUPT = W_WOT + (size_t)1024 * 1024 * 2;
constexpr size_t W_WDOWNT = W_WUPT + (size_t)5632 * 1024 * 2;
constexpr size_t W_WPGT = W_WDOWNT + (size_t)1024 * 2816 * 2;
constexpr size_t W_WPET = W_WPGT + (size_t)1024 * 1024 * 2;
constexpr size_t W_WQLT = W_WPET + (size_t)1024 * 256 * 2;
constexpr size_t W_PEB = W_WQLT + (size_t)2048 * 256 * 2;
constexpr size_t W_R = al(W_PEB + (size_t)TT * 256 * 2);
constexpr size_t W_XB = W_R;
constexpr size_t W_Z = al(W_XB + (size_t)TT * 1024 * 2);
constexpr size_t W_R2 = al(W_Z + (size_t)TT * INW * 4);
constexpr size_t W_QN = W_R2;
constexpr size_t W_CB = al(W_QN + (size_t)TT * 256 * 2);
constexpr size_t W_DB = al(W_CB + (size_t)TT * 256 * 2);
constexpr size_t W_KRB = al(W_DB + (size_t)TT * 512 * 2);
constexpr size_t W_END1 = al(W_KRB + (size_t)TP * 32 * 2);
constexpr size_t W_QBUF = W_R;
constexpr size_t W_KG = al(W_QBUF + (size_t)TT * 768 * 2);
constexpr size_t W_VT = al(W_KG + (size_t)8 * TP * 96 * 2);
constexpr size_t W_QLAT = al(W_VT + (size_t)8 * 64 * TP * 2);
constexpr size_t W_OBUF = al(W_QLAT + (size_t)TS * 2048 * 2);
static_assert(W_OBUF + (size_t)TT * 1024 * 2 <= W_R2, "mid overlay overflow");
constexpr size_t W_OPART = W_R2;
constexpr size_t W_ML = al(W_OPART + (size_t)16 * NSP * 128 * 256 * 4);
static_assert(W_ML + (size_t)16 * NSP * 128 * 2 * 4 <= W_END1, "partials overflow");
constexpr size_t W_X1B = W_R;
constexpr size_t W_ACT = al(W_X1B + (size_t)TT * 1024 * 2);
constexpr size_t W_PLE = al(W_ACT + (size_t)TT * DFF * 2);
constexpr size_t W_END2 = al(W_PLE + (size_t)TT * 1024 * 2);
constexpr size_t W_BAR = W_END1 > W_END2 ? W_END1 : W_END2;
constexpr size_t W_TOTAL = W_BAR + 16384;
static_assert(W_TOTAL <= (size_t)256 * 1024 * 1024, "workspace over 256 MiB");

constexpr int HALF_BYTES = 73728;
constexpr int SMEM_BYTES = 2 * HALF_BYTES;

struct Params { const float* in[26]; float* out; char* ws; };

DI unsigned pk2(float a, float b) { f32x2 v = {a, b}; return __builtin_bit_cast(unsigned, __builtin_convertvector(v, bf2_t)); }
DI u16 bf1(float a) { return (u16)(pk2(a, 0.f) & 0xffffu); }
DI float bf2f(u16 v) { return __uint_as_float(((unsigned)v) << 16); }
DI float wave_sum(float v) { for (int o = 32; o > 0; o >>= 1) v += __shfl_xor(v, o); return v; }
DI float fexp2(float x) { return __builtin_amdgcn_exp2f(x); }
DI float half_max(float v) { auto r = __builtin_amdgcn_permlane32_swap(__float_as_uint(v), __float_as_uint(v), false, false); return fmaxf(__uint_as_float(r[0]), __uint_as_float(r[1])); }
DI float half_sum(float v) { auto r = __builtin_amdgcn_permlane32_swap(__float_as_uint(v), __float_as_uint(v), false, false); return __uint_as_float(r[0]) + __uint_as_float(r[1]); }

template <bool GUARD = false>
DI void gemm_main(const u16* __restrict__ A, size_t lda, int rlo, int rhi,
                  const u16* __restrict__ B0, const u16* __restrict__ B1, size_t ldb,
                  int K, f32x16 (&acc)[2][2], char* smem) {
  const int tid = TIDX, lane = tid & 63, wave = tid >> 6;
  const int wm = wave >> 1, wn = wave & 1, r = lane & 31, h = lane >> 5;
  const int crow = tid >> 3, kc = tid & 7;
  const u16* pa[4];
#pragma unroll
  for (int i = 0; i < 4; ++i) {
    int rw = crow + 32 * i;
    if (GUARD) rw = rw < rlo ? rlo : (rw >= rhi ? rhi - 1 : rw);
    pa[i] = A + (ptrdiff_t)rw * (ptrdiff_t)lda + kc * 8;
  }
  const u16* pb0 = B0 + (size_t)crow * ldb + kc * 8;
  const u16* pb1 = B1 + (size_t)crow * ldb + kc * 8;
  bool va[4];
#pragma unroll
  for (int i = 0; i < 4; ++i) va[i] = (crow + 32 * i >= rlo) && (crow + 32 * i < rhi);
  u32x4 ra0[4], rb0[4], ra1[4], rb1[4];
  const int nk = K >> 6;
  const u32x4 zz = {0u, 0u, 0u, 0u};
#define G_LOAD(RA, RB, KT)                                                                     \
  {                                                                                            \
    const int k0_ = (KT) << 6;                                                                 \
    _Pragma("unroll") for (int i = 0; i < 4; ++i) {                                            \
      const u32x4 t_ = *(const u32x4*)(pa[i] + k0_);                                           \
      RA[i] = (!GUARD || va[i]) ? t_ : zz;                                                     \
    }                                                                                          \
    RB[0] = *(const u32x4*)(pb0 + k0_);                                                        \
    RB[1] = *(const u32x4*)(pb0 + 32 * ldb + k0_);                                             \
    RB[2] = *(const u32x4*)(pb1 + k0_);                                                        \
    RB[3] = *(const u32x4*)(pb1 + 32 * ldb + k0_);                                             \
    __builtin_amdgcn_sched_barrier(0);                                                         \
  }
#define G_WRITE(RA, RB, ST)                                                                    \
  {                                                                                            \
    char* as_ = smem + (ST) * 36864 + crow * 144 + kc * 16;                                    \
    __builtin_amdgcn_sched_barrier(0);                                                         \
    _Pragma("unroll") for (int i = 0; i < 4; ++i) *(u32x4*)(as_ + i * 32 * 144) = RA[i];        \
    _Pragma("unroll") for (int i = 0; i < 4; ++i) *(u32x4*)(as_ + 18432 + i * 32 * 144) = RB[i]; \
    __builtin_amdgcn_sched_barrier(0);                                                         \
  }
#define G_COMPUTE(ST)                                                                          \
  {                                                                                            \
    const char* as_ = smem + (ST) * 36864 + (wm * 64 + r) * 144 + h * 16;                      \
    const char* bs_ = smem + (ST) * 36864 + 18432 + (wn * 64 + r) * 144 + h * 16;              \
    bf16x8 fa[2], fb[2][2];          \
    fb[0][0] = *(const bf16x8*)(bs_);                                                          \
    fb[0][1] = *(const bf16x8*)(bs_ + 32 * 144);                                               \
    fa[0] = *(const bf16x8*)(as_);                                                             \
    fa[1] = *(const bf16x8*)(as_ + 32 * 144);                                                  \
    _Pragma("unroll") for (int ks = 0; ks < 4; ++ks) {                                         \
      if (ks < 3) {                                                                            \
        fb[(ks + 1) & 1][0] = *(const bf16x8*)(bs_ + (ks + 1) * 32);                           \
        fb[(ks + 1) & 1][1] = *(const bf16x8*)(bs_ + 32 * 144 + (ks + 1) * 32);                \
      }                                                                                        \
      _Pragma("unroll") for (int mi = 0; mi < 2; ++mi) {                                       \
        acc[mi][0] = MFMA(fa[mi], fb[ks & 1][0], acc[mi][0]);                                  \
        acc[mi][1] = MFMA(fa[mi], fb[ks & 1][1], acc[mi][1]);                                  \
        if (ks < 3) fa[mi] = *(const bf16x8*)(as_ + mi * 32 * 144 + (ks + 1) * 32);            \
      }                                                                                        \
    }                                                                                          \
  }
  if (nk == 1) {
    G_LOAD(ra0, rb0, 0)
    G_WRITE(ra0, rb0, 0)
    __syncthreads();
    G_COMPUTE(0)
    __syncthreads();
    return;
  }
  G_LOAD(ra0, rb0, 0)
  G_LOAD(ra1, rb1, 1)
  G_WRITE(ra0, rb0, 0)
  G_LOAD(ra0, rb0, (2 < nk ? 2 : nk - 1))
  __syncthreads();
  for (int kt = 0; kt + 2 < nk; kt += 2) {
    G_WRITE(ra1, rb1, 1)
    G_LOAD(ra1, rb1, kt + 3)
    G_COMPUTE(0)
    __syncthreads();
    G_WRITE(ra0, rb0, 0)
    G_LOAD(ra0, rb0, (kt + 4 < nk ? kt + 4 : nk - 1))
    G_COMPUTE(1)
    __syncthreads();
  }
  G_WRITE(ra1, rb1, 1)
  G_COMPUTE(0)
  __syncthreads();
  G_COMPUTE(1)
  __syncthreads();
}

DI bool raster(int it, int NRT, int NCT, int& rt, int& ct) {
  const int b = blockIdx.x, per = gridDim.x >> 3;
  const int ord = (it * 8 + (b & 7)) * per + (b >> 3);
  const int sr = ord / (8 * NCT), rem = ord - sr * 8 * NCT;
  ct = rem >> 3;
  rt = sr * 8 + (rem & 7);
  return sr < ((NRT + 7) >> 3);
}


template <bool GUARD = false>
DI void gemm256(const u16* __restrict__ A, size_t lda, int rlo, int rhi,
                const u16* __restrict__ B0, const u16* __restrict__ B1, size_t ldb,
                int K, f32x16 (&acc)[4][2], char* smem) {
  const int tid = TID8, lane = tid & 63, wave = tid >> 6;
  const int wm = wave >> 2, wn = wave & 3, r = lane & 31, h = lane >> 5;
  const int crow = tid >> 3, kc = tid & 7;
  const u16* pa[4];
  bool va[4];
#pragma unroll
  for (int i = 0; i < 4; ++i) {
    int rw = crow + 64 * i;
    va[i] = (rw >= rlo) && (rw < rhi);
    if (GUARD) rw = rw < rlo ? rlo : (rw >= rhi ? rhi - 1 : rw);
    pa[i] = A + (ptrdiff_t)rw * (ptrdiff_t)lda + kc * 8;
  }
  const u16* pb0 = B0 + (size_t)crow * ldb + kc * 8;
  const u16* pb1 = B1 + (size_t)crow * ldb + kc * 8;
  u32x4 ra[4], rb[4];
  const int nk = K >> 6;
  const u32x4 zz = {0u, 0u, 0u, 0u};
#define H_LOADA(KT)                                                                            \
  {                                                                                            \
    const int k0_ = (KT) << 6;                                                                 \
    _Pragma("unroll") for (int i = 0; i < 4; ++i) {                                            \
      const u32x4 t_ = *(const u32x4*)(pa[i] + k0_);                                           \
      ra[i] = (!GUARD || va[i]) ? t_ : zz;                                                     \
    }                                                                                          \
    __builtin_amdgcn_sched_barrier(0);                                                         \
  }
#define H_LOADB(KT)                                                                            \
  {                                                                                            \
    const int k0_ = (KT) << 6;                                                                 \
    rb[0] = *(const u32x4*)(pb0 + k0_);                                                        \
    rb[1] = *(const u32x4*)(pb0 + 64 * ldb + k0_);                                             \
    rb[2] = *(const u32x4*)(pb1 + k0_);                                                        \
    rb[3] = *(const u32x4*)(pb1 + 64 * ldb + k0_);                                             \
    __builtin_amdgcn_sched_barrier(0);                                                         \
  }
#define H_LOAD(KT) { H_LOADA(KT) H_LOADB(KT) }
#define H_WRITE(ST)                                                                            \
  {                                                                                            \
    char* as_ = smem + (ST) * 73728 + crow * 144 + kc * 16;                                    \
    __builtin_amdgcn_sched_barrier(0);                                                         \
    _Pragma("unroll") for (int i = 0; i < 4; ++i) *(u32x4*)(as_ + i * 64 * 144) = ra[i];        \
    _Pragma("unroll") for (int i = 0; i < 4; ++i) *(u32x4*)(as_ + 36864 + i * 64 * 144) = rb[i]; \
    __builtin_amdgcn_sched_barrier(0);                                                         \
  }
#define H_FRAGS(FA, FB, KS)                                                                    \
  {                                                                                            \
    FB[0] = *(const bf16x8*)(bs_ + (KS) * 32);                                                 \
    FB[1] = *(const bf16x8*)(bs_ + 32 * 144 + (KS) * 32);                                      \
    _Pragma("unroll") for (int mi = 0; mi < 4; ++mi) FA[mi] = *(const bf16x8*)(as_ + mi * 32 * 144 + (KS) * 32); \
  }
#define H_MFMAS(FA, FB)                                                                        \
  {                                                                                            \
    _Pragma("unroll") for (int mi = 0; mi < 4; ++mi) {                                         \
      acc[mi][0] = MFMA(FA[mi], FB[0], acc[mi][0]);                                            \
      acc[mi][1] = MFMA(FA[mi], FB[1], acc[mi][1]);                                            \
    }                                                                                          \
  }
#define H_ITER(STC, DOW, STW, DOL, KTL)                                                        \
  {                                                                                            \
    const char* as_ = smem + (STC) * 73728 + (wm * 128 + r) * 144 + h * 16;                    \
    const char* bs_ = smem + (STC) * 73728 + 36864 + (wn * 64 + r) * 144 + h * 16;             \
    char* ws_ = smem + (STW) * 73728 + crow * 144 + kc * 16;                                   \
    bf16x8 fa[4], fb[2][2];                                                                    \
    fb[0][0] = *(const bf16x8*)(bs_);                                                          \
    fb[0][1] = *(const bf16x8*)(bs_ + 32 * 144);                                               \
    _Pragma("unroll") for (int mi = 0; mi < 4; ++mi) fa[mi] = *(const bf16x8*)(as_ + mi * 32 * 144); \
    _Pragma("unroll") for (int ks = 0; ks < 4; ++ks) {                                         \
      if (ks < 3) {                                                                            \
        fb[(ks + 1) & 1][0] = *(const bf16x8*)(bs_ + (ks + 1) * 32);                           \
        fb[(ks + 1) & 1][1] = *(const bf16x8*)(bs_ + 32 * 144 + (ks + 1) * 32);                \
      }                                                                                        \
      _Pragma("unroll") for (int mi = 0; mi < 4; ++mi) {                                       \
        acc[mi][0] = MFMA(fa[mi], fb[ks & 1][0], acc[mi][0]);                                  \
        acc[mi][1] = MFMA(fa[mi], fb[ks & 1][1], acc[mi][1]);                                  \
        if (ks < 3) fa[mi] = *(const bf16x8*)(as_ + mi * 32 * 144 + (ks + 1) * 32);            \
      }                                                                                        \
      if (ks == 0 && (DOW)) {                                                                  \
        __builtin_amdgcn_sched_barrier(0);                                                     \
        _Pragma("unroll") for (int i = 0; i < 4; ++i) *(u32x4*)(ws_ + i * 64 * 144) = ra[i];   \
        __builtin_amdgcn_sched_barrier(0);                                                     \
        if (DOL) H_LOADA(KTL)                                                                  \
      }                                                                                        \
      if (ks == 1 && (DOW)) {                                                                  \
        __builtin_amdgcn_sched_barrier(0);                                                     \
        _Pragma("unroll") for (int i = 0; i < 4; ++i) *(u32x4*)(ws_ + 36864 + i * 64 * 144) = rb[i]; \
        __builtin_amdgcn_sched_barrier(0);                                                     \
      }                                                                                        \
      if (ks == 1 && (DOL)) H_LOADB(KTL)                                                       \
    }                                                                                          \
  }
  H_LOAD(0)
  H_WRITE(0)
  H_LOAD(1)
  __syncthreads();
  for (int kt = 0; kt + 2 < nk; kt += 2) {
    H_ITER(0, 1, 1, 1, kt + 2)
    __syncthreads();
    H_ITER(1, 1, 0, 1, kt + 3)
    __syncthreads();
  }
  H_ITER(0, 1, 1, 0, 0)
  __syncthreads();
  H_ITER(1, 0, 0, 0, 0)
  __syncthreads();
}

DI void zero_acc8(f32x16 (&acc)[4][2]) {
#pragma unroll
  for (int i = 0; i < 4; ++i)
#pragma unroll
    for (int j = 0; j < 2; ++j)
#pragma unroll
      for (int e = 0; e < 16; ++e) acc[i][j][e] = 0.f;
}
#define EPI256_BEGIN                                                                   \
  {                                                                                    \
    const int t8_ = TID8, lane_ = t8_ & 63, wave_ = t8_ >> 6;                          \
    const int wm_ = wave_ >> 2, wn_ = wave_ & 3, rr_ = lane_ & 31, hh_ = lane_ >> 5;   \
    _Pragma("unroll") for (int mi = 0; mi < 4; ++mi)                                   \
    _Pragma("unroll") for (int ni = 0; ni < 2; ++ni)                                   \
    _Pragma("unroll") for (int reg = 0; reg < 16; ++reg) {                             \
      const int row = wm_ * 128 + mi * 32 + (reg & 3) + 8 * (reg >> 2) + 4 * hh_;      \
      const int col = wn_ * 64 + ni * 32 + rr_;                                        \
      const float v = acc[mi][ni][reg];
#define EPI256_END }}

DI void tile256(int t, int& rt, int& ct) { const int x = t & 7, j = t >> 3; rt = x * 8 + (j >> 2); ct = j & 3; }

DI bool rasterV(int it, int NRT, int NCT, int& rt, int& ct, int xrot = 0) {
  const int per = VG >> 3;
  const int ord = (it * 8 + (int)((blockIdx.x + xrot) & 7)) * per + (int)(blockIdx.x >> 3) * 2 + HB;
  const int sr = ord / (8 * NCT), rem = ord - sr * 8 * NCT;
  ct = rem >> 3;
  rt = sr * 8 + (rem & 7);
  return rt < NRT;
}
DI int rasterV_iters(int NRT, int NCT) { return (((NRT + 7) >> 3) * 8 * NCT + VG - 1) / VG; }

DI void zero_acc(f32x16 (&acc)[2][2]) {
#pragma unroll
  for (int i = 0; i < 2; ++i)
#pragma unroll
    for (int j = 0; j < 2; ++j)
#pragma unroll
      for (int e = 0; e < 16; ++e) acc[i][j][e] = 0.f;
}

#define EPI_BEGIN                                                                      \
  {                                                                                    \
    const int lane_ = TIDX & 63, wave_ = TIDX >> 6;                      \
    const int wm_ = wave_ >> 1, wn_ = wave_ & 1, rr_ = lane_ & 31, hh_ = lane_ >> 5;   \
    _Pragma("unroll") for (int mi = 0; mi < 2; ++mi)                                   \
    _Pragma("unroll") for (int ni = 0; ni < 2; ++ni)                                   \
    _Pragma("unroll") for (int reg = 0; reg < 16; ++reg) {                             \
      const int row = wm_ * 64 + mi * 32 + (reg & 3) + 8 * (reg >> 2) + 4 * hh_;       \
      const int col = wn_ * 64 + ni * 32 + rr_;                                        \
      const float v = acc[mi][ni][reg];
#define EPI_END }}

DI f32x16 small_gemm32(const u16* __restrict__ A, size_t lda, const u16* __restrict__ Bt, size_t ldb, int K, char* smem) {
  const int tid = TIDX, lane = tid & 63, wave = tid >> 6, r = lane & 31, h = lane >> 5;
  const int kw = K >> 2;
  const u16* pa = A + (size_t)r * lda + wave * kw + 8 * h;
  const u16* pb = Bt + (size_t)r * ldb + wave * kw + 8 * h;
  f32x16 c;
#pragma unroll
  for (int e = 0; e < 16; ++e) c[e] = 0.f;
#pragma unroll 4
  for (int ks = 0; ks < (kw >> 4); ++ks) {
    const bf16x8 a = *(const bf16x8*)(pa + 16 * ks);
    const bf16x8 b = *(const bf16x8*)(pb + 16 * ks);
    c = MFMA(a, b, c);
  }
  float* red = (float*)smem;
#pragma unroll
  for (int e = 0; e < 16; ++e) red[(wave * 16 + e) * 64 + lane] = c[e];
  __syncthreads();
  f32x16 o;
#pragma unroll
  for (int e = 0; e < 16; ++e) o[e] = red[e * 64 + lane] + red[(16 + e) * 64 + lane] + red[(32 + e) * 64 + lane] + red[(48 + e) * 64 + lane];
  __syncthreads();
  return o;
}
DI f32x16 small_gemm32w8(const u16* __restrict__ A, size_t lda, const u16* __restrict__ Bt, size_t ldb, int K, char* smem) {
  const int tid = TID8, lane = tid & 63, wave = tid >> 6, r = lane & 31, h = lane >> 5;
  const int kw = K >> 3;
  const u16* pa = A + (size_t)r * lda + wave * kw + 8 * h;
  const u16* pb = Bt + (size_t)r * ldb + wave * kw + 8 * h;
  f32x16 c;
#pragma unroll
  for (int e = 0; e < 16; ++e) c[e] = 0.f;
#pragma unroll 4
  for (int ks = 0; ks < (kw >> 4); ++ks) {
    const bf16x8 a = *(const bf16x8*)(pa + 16 * ks);
    const bf16x8 b = *(const bf16x8*)(pb + 16 * ks);
    c = MFMA(a, b, c);
  }
  float* red = (float*)smem;
#pragma unroll
  for (int e = 0; e < 16; ++e) red[(wave * 16 + e) * 64 + lane] = c[e];
  __syncthreads();
  f32x16 o;
#pragma unroll
  for (int e = 0; e < 16; ++e) o[e] = 0.f;
#pragma unroll 1
  for (int w8 = 0; w8 < 8; ++w8) {
#pragma unroll
    for (int e = 0; e < 16; ++e) o[e] += red[(w8 * 16 + e) * 64 + lane];
  }
  __syncthreads();
  return o;
}
#define SMALL8_EPI_BEGIN(C)                                                            \
  if ((TID8 >> 6) == 0) {                                                              \
    const int lane_ = TID8 & 63, rr_ = lane_ & 31, hh_ = lane_ >> 5;                   \
    _Pragma("unroll") for (int reg = 0; reg < 16; ++reg) {                             \
      const int row = (reg & 3) + 8 * (reg >> 2) + 4 * hh_;                            \
      const int col = rr_;                                                             \
      const float v = (C)[reg];
#define SMALL_EPI_BEGIN(C)                                                             \
  if ((TIDX >> 6) == 0) {                                                              \
    const int lane_ = TIDX & 63, rr_ = lane_ & 31, hh_ = lane_ >> 5;                   \
    _Pragma("unroll") for (int reg = 0; reg < 16; ++reg) {                             \
      const int row = (reg & 3) + 8 * (reg >> 2) + 4 * hh_;                            \
      const int col = rr_;                                                             \
      const float v = (C)[reg];
#define SMALL_EPI_END }}

struct TJob { const float* src; u16* dst; int K, N, k0, n0; };
DI void tt_load(const TJob& j, f32x4 (&v)[4]) {
  const int tid = TIDX;
#pragma unroll
  for (int i = 0; i < 4; ++i) {
    const int c = tid + 256 * i, kk = c >> 4, n = j.n0 + (c & 15) * 4;
    const int nc = n < j.N ? n : 0;
    v[i] = __builtin_nontemporal_load((const f32x4*)(j.src + (size_t)(j.k0 + kk) * j.N + nc));
    if (n >= j.N) v[i] = (f32x4){0.f, 0.f, 0.f, 0.f};
  }
}
DI void tt_store(const TJob& j, const f32x4 (&v)[4], float* s, bool ok) {
  const int tid = TIDX;
#pragma unroll
  for (int i = 0; i < 4; ++i) {
    const int c = tid + 256 * i, kk = c >> 4, n4 = (c & 15) * 4;
    s[kk * 65 + n4] = v[i][0]; s[kk * 65 + n4 + 1] = v[i][1]; s[kk * 65 + n4 + 2] = v[i][2]; s[kk * 65 + n4 + 3] = v[i][3];
  }
  __syncthreads();
  const int nn = tid >> 2, kq = (tid & 3) * 16;
#pragma unroll
  for (int q = 0; q < 2; ++q) {
    u32x4 o;
#pragma unroll
    for (int e = 0; e < 4; ++e) o[e] = pk2(s[(kq + 8 * q + 2 * e) * 65 + nn], s[(kq + 8 * q + 2 * e + 1) * 65 + nn]);
    if (ok) *(u32x4*)(j.dst + (size_t)(j.n0 + nn) * j.K + j.k0 + kq + 8 * q) = o;
  }
  __syncthreads();
}

DI void cvt_range(const float* __restrict__ src, u16* __restrict__ dst, size_t n4, size_t gt, size_t gs) {
#pragma unroll 8
  for (size_t i = gt; i < n4; i += gs) {
    const float4 v = ((const float4*)src)[i];
    uint2 o; o.x = pk2(v.x, v.y); o.y = pk2(v.z, v.w);
    ((uint2*)dst)[i] = o;
  }
}

DI void phase0(const Params& p, char* smem_) {
  char* ws = p.ws;
  char* smem = smem_ + HB * HALF_BYTES;
  {
    auto decode = [&](int t) {
      TJob j;
      int K, N, NT, base; const float* src; size_t off;
      if (t < 288)       { src = p.in[8];  off = W_WINT;   K = 1024; N = 1056; base = 0; }
      else if (t < 336)  { src = p.in[10]; off = W_WQBT;   K = 256;  N = 768;  base = 288; }
      else if (t < 400)  { src = p.in[12]; off = W_WKVBT;  K = 256;  N = 1024; base = 336; }
      else if (t < 416)  { src = p.in[13]; off = W_WPOOLT; K = 512;  N = 128;  base = 400; }
      else if (t < 672)  { src = p.in[15]; off = W_WOT;    K = 1024; N = 1024; base = 416; }
      else if (t < 2080) { src = p.in[18]; off = W_WUPT;   K = 1024; N = 5632; base = 672; }
      else if (t < 2784) { src = p.in[21]; off = W_WDOWNT; K = 2816; N = 1024; base = 2080; }
      else if (t < 3040) { src = p.in[22]; off = W_WPGT;   K = 1024; N = 1024; base = 2784; }
      else               { src = p.in[23]; off = W_WPET;   K = 256;  N = 1024; base = 3040; }
      (void)NT;
      const int KT = K >> 6, tt = t - base;
      j.src = src; j.dst = (u16*)(ws + off); j.K = K; j.N = N; j.k0 = (tt % KT) * 64; j.n0 = (tt / KT) * 64;
      return j;
    };
    constexpr size_t C0 = (size_t)TP * 1024 / 4, C1 = C0 + (size_t)TS * 1024 / 4, C2 = C1 + (size_t)TP * 256 / 4,
                     C3 = C2 + (size_t)TS * 256 / 4, C4 = C3 + (size_t)256 * 768 / 4, CT = C4 + (size_t)256 * 1024 / 4;
    auto cdec = [&](size_t idx, const f32x4*& src, uint2*& dst) {
      if (idx < C0)      { src = (const f32x4*)p.in[0] + idx;         dst = (uint2*)(ws + W_XB) + idx; }
      else if (idx < C1) { src = (const f32x4*)p.in[1] + (idx - C0);  dst = (uint2*)(ws + W_XB) + idx; }
      else if (idx < C2) { src = (const f32x4*)p.in[6] + (idx - C1);  dst = (uint2*)(ws + W_PEB) + (idx - C1); }
      else if (idx < C3) { src = (const f32x4*)p.in[7] + (idx - C2);  dst = (uint2*)(ws + W_PEB) + (idx - C1); }
      else if (idx < C4) { src = (const f32x4*)p.in[10] + (idx - C3); dst = (uint2*)(ws + W_WQB) + (idx - C3); }
      else               { src = (const f32x4*)p.in[12] + (idx - C4); dst = (uint2*)(ws + W_WKVB) + (idx - C4); }
    };
    const size_t gtc = (size_t)VB * 256 + TIDX, nthr = (size_t)VG * 256;
    const int NTILE = 3104, nIt = (NTILE + VG - 1) / VG;
    int t = VB;
    bool ok = t < NTILE;
    TJob cur = decode(ok ? t : 0);
    f32x4 v[4];
    tt_load(cur, v);
    for (int i = 0; i < nIt; ++i) {
      f32x4 cv[6];
      uint2* cd[6];
      bool cok[6];
#pragma unroll
      for (int u = 0; u < 6; ++u) {
        const size_t idx = (size_t)(i * 6 + u) * nthr + gtc;
        cok[u] = idx < CT;
        const f32x4* src;
        cdec(cok[u] ? idx : CT - 1, src, cd[u]);
        cv[u] = __builtin_nontemporal_load(src);
      }
      const int tn = t + VG;
      const bool okn = tn < NTILE;
      const TJob nxt = decode(okn ? tn : 0);
      f32x4 vn[4];
      tt_load(nxt, vn);
      tt_store(cur, v, (float*)smem, ok);
      cur = nxt; ok = okn; t = tn;
#pragma unroll
      for (int q = 0; q < 4; ++q) v[q] = vn[q];
#pragma unroll
      for (int u = 0; u < 6; ++u)
        if (cok[u]) { uint2 o; o.x = pk2(cv[u][0], cv[u][1]); o.y = pk2(cv[u][2], cv[u][3]); *cd[u] = o; }
    }
    for (size_t idx = (size_t)nIt * 6 * nthr + gtc; idx < CT; idx += nthr) {
      const f32x4* src; uint2* dst;
      cdec(idx, src, dst);
      const f32x4 c = *src;
      uint2 o; o.x = pk2(c[0], c[1]); o.y = pk2(c[2], c[3]);
      *dst = o;
    }
  }
  const size_t gt = (size_t)VB * 256 + TIDX, gs = (size_t)VG * 256;
  float2* rope = (float2*)(ws + W_ROPE);
  for (size_t i = gt; i < (size_t)16384 * 16; i += gs) {
    const int pos = (int)(i >> 4), k = (int)(i & 15);
    const float inv = 1.0f / powf(10000.0f, (float)(2 * k) / 32.0f);
    const float ang = (float)pos * inv;
    const double ad = (double)ang;
    const double nrev = rint(ad * 0.15915494309189535);
    const float red = (float)(ad - nrev * 6.283185307179586);
    rope[i] = make_float2(__cosf(red), __sinf(red));
  }
  if (gt < 64) ((int*)(ws + W_CNT))[gt] = 0;
}

DI void phase1(const Params& p, char* smem) {
  char* ws = p.ws;
  char* hs = smem + HB * HALF_BYTES;
  float* z = (float*)(ws + W_Z);
  for (int t = blockIdx.x; t < 256; t += gridDim.x) {
    int rt, ct;
    tile256(t, rt, ct);
    f32x16 acc[4][2];
    zero_acc8(acc);
    const u16* A = (const u16*)(ws + W_XB) + (size_t)rt * 256 * 1024;
    const u16* B = (const u16*)(ws + W_WINT) + (size_t)ct * 256 * 1024;
    gemm256(A, 1024, 0, 256, B, B + 128 * 1024, 1024, 1024, acc, smem);
    EPI256_BEGIN
      z[(size_t)(rt * 256 + row) * INW + ct * 256 + col] = v;
    EPI256_END
  }
  for (int q = blockIdx.x; q < 520 + 256; q += gridDim.x) {
    int r0, c0;
    if (q < 520) { r0 = q * 32; c0 = 1024; } else { r0 = TP + ((q - 520) >> 5) * 32; c0 = ((q - 520) & 31) * 32; }
    const f32x16 c = small_gemm32w8((const u16*)(ws + W_XB) + (size_t)r0 * 1024, 1024, (const u16*)(ws + W_WINT) + (size_t)c0 * 1024, 1024, 1024, smem);
    SMALL8_EPI_BEGIN(c)
      z[(size_t)(r0 + row) * INW + c0 + col] = v;
    SMALL_EPI_END
  }
  for (int q0 = blockIdx.x * 2; q0 < 32; q0 += VG) {
    const int q = q0 + HB;
    f32x16 acc[2][2];
    zero_acc(acc);
    const int hd = q >> 2, lt = (q >> 1) & 1, kt = q & 1;
    const u16* A = (const u16*)(ws + W_WKVB) + (size_t)(lt * 128) * 1024 + hd * 128;
    const u16* B = (const u16*)(ws + W_WQB) + (size_t)(kt * 128) * 768 + hd * 96;
    gemm_main(A, 1024, 0, 128, B, B + 64 * 768, 768, 64, acc, hs);
    u16* o = (u16*)(ws + W_WQLT);
    EPI_BEGIN
      o[(size_t)(hd * 256 + lt * 128 + row) * 256 + kt * 128 + col] = bf1(v);
    EPI_END
  }
}

DI void phase2(const Params& p) {
  char* ws = p.ws;
  const float* z = (const float*)(ws + W_Z);
  const float2* rope = (const float2*)(ws + W_ROPE);
  const int lane = TIDX & 63;
  const int gw = VB * 4 + (TIDX >> 6), nw = VG * 4;
  const float4 gq = ((const float4*)p.in[9])[lane];
  const float4 gkv = ((const float4*)p.in[11])[lane];
  for (int row = gw; row < TT; row += nw) {
    const float* zr = z + (size_t)row * INW;
    const bool samp = row >= TP;
    const int srow = row - TP, sb = srow >> 4, st = srow & 15;
    const float4 ld_q = ((const float4*)zr)[lane];
    const float4 ld_c = ((const float4*)(zr + 256))[lane];
    const float ld_x1 = zr[512 + (lane & 15)], ld_x2 = zr[528 + (lane & 15)];
    const float4 ld_u0 = ((const float4*)(zr + 544 + lane * 8))[0], ld_u1 = ((const float4*)(zr + 544 + lane * 8))[1];
    const float2 ld_cs = rope[(samp ? 4096 + st : row) * 16 + (lane & 15)];
    {
      const float4 v = ld_q;
      const float ss = wave_sum(v.x * v.x + v.y * v.y + v.z * v.z + v.w * v.w);
      const float rs = rsqrtf(ss * (1.0f / 256.0f) + 1e-6f);
      uint2 o; o.x = pk2(v.x * rs * gq.x, v.y * rs * gq.y); o.y = pk2(v.z * rs * gq.z, v.w * rs * gq.w);
      ((uint2*)((u16*)(ws + W_QN) + (size_t)row * 256))[lane] = o;
    }
    {
      const float4 v = ld_c;
      const float ss = wave_sum(v.x * v.x + v.y * v.y + v.z * v.z + v.w * v.w);
      const float rs = rsqrtf(ss * (1.0f / 256.0f) + 1e-6f);
      float4 c; c.x = v.x * rs * gkv.x; c.y = v.y * rs * gkv.y; c.z = v.z * rs * gkv.z; c.w = v.w * rs * gkv.w;
      float* co = samp ? p.out + O_CKVS + (size_t)srow * 256 : p.out + O_CKVP + (size_t)row * 256;
      ((float4*)co)[lane] = c;
      uint2 o; o.x = pk2(c.x, c.y); o.y = pk2(c.z, c.w);
      ((uint2*)((u16*)(ws + W_CB) + (size_t)row * 256))[lane] = o;
    }
    if (lane < 16) {
      const float x1 = ld_x1, x2 = ld_x2;
      const float2 cs = ld_cs;
      const float o1 = x1 * cs.x - x2 * cs.y, o2 = x2 * cs.x + x1 * cs.y;
      float* ko = samp ? p.out + O_KRS + (size_t)srow * 32 : p.out + O_KRP + (size_t)row * 32;
      ko[lane] = o1; ko[16 + lane] = o2;
      if (!samp) {
        u16* kr = (u16*)(ws + W_KRB) + (size_t)row * 32;
        kr[lane] = bf1(o1); kr[16 + lane] = bf1(o2);
      }
    }
    {
      const float* ur = zr + 544 + lane * 8;
      const float4 u0 = ld_u0, u1 = ld_u1;
      float* po = nullptr;
      if (!samp) { if (row >= TP - 15) po = p.out + O_POOLP + (size_t)(row - (TP - 15)) * 512; }
      else if (st >= 1) po = p.out + O_POOLS + ((size_t)sb * 15 + (st - 1)) * 512;
      if (po) { ((float4*)(po + lane * 8))[0] = u0; ((float4*)(po + lane * 8))[1] = u1; }
      if (samp) {
        const int g = lane >> 4, w = 2 << g;
        float4 s0 = u0, s1 = u1;
        for (int i = 1; i < 16; ++i) {
          if (i < w) {
            const float* src = (st - i >= 0) ? ur - (size_t)i * INW : p.in[4] + ((size_t)sb * 15 + (15 + st - i)) * 512 + lane * 8;
            const float4 a = ((const float4*)src)[0], b = ((const float4*)src)[1];
            s0.x += a.x; s0.y += a.y; s0.z += a.z; s0.w += a.w;
            s1.x += b.x; s1.y += b.y; s1.z += b.z; s1.w += b.w;
          }
        }
        const float ic = 1.0f / (float)w;
        uint4 o;
        o.x = pk2(s0.x * ic - u0.x, s0.y * ic - u0.y); o.y = pk2(s0.z * ic - u0.z, s0.w * ic - u0.w);
        o.z = pk2(s1.x * ic - u1.x, s1.y * ic - u1.y); o.w = pk2(s1.z * ic - u1.z, s1.w * ic - u1.w);
        ((uint4*)((u16*)(ws + W_DB) + (size_t)row * 512))[lane] = o;
      }
    }
  }
  for (int task = gw; task < (TP / 32) * 4; task += nw) {
    const int g = task & 3, j0 = (task >> 2) * 32, W = 2 << g;
    const int col = 128 * g + 2 * lane;
    const float* up = z + 544 + col;
    u16* db = (u16*)(ws + W_DB) + col;
    float sx = 0.f, sy = 0.f;
#pragma unroll 4
    for (int i = 1; i <= 16; ++i) {
      const int jj = j0 - i;
      const float2 t = *(const float2*)(up + (size_t)(jj >= 0 ? jj : 0) * INW);
      const bool ok = (i <= W) && (jj >= 0);
      sx += ok ? t.x : 0.f; sy += ok ? t.y : 0.f;
    }
#pragma unroll 8
    for (int j = j0; j < j0 + 32; ++j) {
      const float2 v = *(const float2*)(up + (size_t)j * INW);
      const int jo = j - W;
      const float2 o = *(const float2*)(up + (size_t)(jo >= 0 ? jo : 0) * INW);
      sx += v.x - (jo >= 0 ? o.x : 0.f);
      sy += v.y - (jo >= 0 ? o.y : 0.f);
      const int cnt = j + 1 < W ? j + 1 : W;
      const float ic = __builtin_amdgcn_rcpf((float)cnt);
      *(unsigned*)(db + (size_t)j * 512) = pk2(sx * ic - v.x, sy * ic - v.y);
    }
  }
}

DI void phase3(const Params& p, char* smem_) {
  char* ws = p.ws;
  char* smem = smem_ + HB * HALF_BYTES;
  const float2* rope = (const float2*)(ws + W_ROPE);
  for (int it = 0, nIt = rasterV_iters(130, 6); it < nIt; ++it) {
    int rt, ct;
    const bool ok = rasterV(it, 130, 6, rt, ct);
    if (!ok) { rt = 0; ct = 0; }
    f32x16 acc[2][2];
    zero_acc(acc);
    {
      const u16* A = (const u16*)(ws + W_QN) + (size_t)rt * 128 * 256;
      const u16* B = (const u16*)(ws + W_WQBT) + (size_t)ct * 128 * 256;
      gemm_main(A, 256, 0, 128, B, B + 64 * 256, 256, 256, acc, smem);
      if (!ok) continue;
      u16* qb = (u16*)(ws + W_QBUF);
      EPI_BEGIN
        const int cg_ = ct * 128 + col, rg_ = rt * 128 + row;
        float o = v * QSCALE;
        const bool is_rope = (((cg_ >> 5) % 3) == 2);
        if (is_rope) {
          const int pos = rg_ < TP ? rg_ : 4096 + ((rg_ - TP) & 15);
          const float2 cs = rope[pos * 16 + (rr_ & 15)];
          const float pr = __shfl_xor(o, 16);
          o = (rr_ < 16) ? o * cs.x - pr * cs.y : o * cs.x + pr * cs.y;
        }
        qb[(size_t)rg_ * 768 + cg_] = bf1(o);
      EPI_END
    }
  }
  for (int it = 0, nIt = rasterV_iters(128, 8); it < nIt; ++it) {
    int rt, hd;
    const bool ok = rasterV(it, 128, 8, rt, hd);
    if (!ok) { rt = 0; hd = 0; }
    f32x16 acc[2][2];
    zero_acc(acc);
    {
      const u16* A = (const u16*)(ws + W_CB) + (size_t)rt * 128 * 256;
      const u16* B = (const u16*)(ws + W_WKVBT) + (size_t)hd * 128 * 256;
      if (ok) {
        const u16* krb = (const u16*)(ws + W_KRB) + (size_t)rt * 128 * 32;
        u16* kg2 = (u16*)(ws + W_KG) + ((size_t)hd * TP + rt * 128) * 96 + 64;
#pragma unroll 2
        for (int i = 0; i < 8; ++i) {
          const int idx = TIDX + 256 * i, rw = idx >> 4, cp = idx & 15;
          *(unsigned*)(kg2 + (size_t)rw * 96 + cp * 2) = *(const unsigned*)(krb + rw * 32 + cp * 2);
        }
      }
      gemm_main(A, 256, 0, 128, B, B + 64 * 256, 256, 256, acc, smem);
      if (!ok) continue;
      const int lane = TIDX & 63, wave = TIDX >> 6, wm = wave >> 1, wn = wave & 1, r = lane & 31, h = lane >> 5;
      if (wn == 0) {
        u16* kg = (u16*)(ws + W_KG) + (size_t)hd * TP * 96;
#pragma unroll
        for (int mi = 0; mi < 2; ++mi)
#pragma unroll
          for (int ni = 0; ni < 2; ++ni)
#pragma unroll
            for (int reg = 0; reg < 16; ++reg) {
              const int row = rt * 128 + wm * 64 + mi * 32 + (reg & 3) + 8 * (reg >> 2) + 4 * h;
              kg[(size_t)row * 96 + ni * 32 + r] = bf1(acc[mi][ni][reg]);
            }
      } else {
        u16* vt = (u16*)(ws + W_VT) + (size_t)hd * 64 * TP;
#pragma unroll
        for (int mi = 0; mi < 2; ++mi)
#pragma unroll
          for (int ni = 0; ni < 2; ++ni)
#pragma unroll
            for (int g = 0; g < 4; ++g) {
              const int dv = ni * 32 + r;
              const int pos = rt * 128 + wm * 64 + mi * 32 + 16 * (g >> 1) + 8 * h + 4 * (g & 1);
              uint2 o;
              o.x = pk2(acc[mi][ni][4 * g], acc[mi][ni][4 * g + 1]);
              o.y = pk2(acc[mi][ni][4 * g + 2], acc[mi][ni][4 * g + 3]);
              *(uint2*)(vt + (size_t)dv * TP + pos) = o;
            }
      }
    }
  }
  const int qlx = (int)(blockIdx.x & 7) - 6, qlj = (int)(blockIdx.x >> 3) * 2 + qlx;
  const bool ql_spread = gridDim.x >= 64;
  for (int q0 = ql_spread ? ((qlx >= 0 && qlj < 16) ? 2 * qlj : 32) : (int)blockIdx.x * 2; q0 < 32; q0 += ql_spread ? 32 : VG) {
    f32x16 acc[2][2];
    zero_acc(acc);
    {
      const int q = q0 + HB;
      const int rt = q >> 4, ct = q & 15;
      const u16* A = (const u16*)(ws + W_QN) + (size_t)(TP + rt * 128) * 256;
      const u16* B = (const u16*)(ws + W_WQLT) + (size_t)ct * 128 * 256;
      gemm_main(A, 256, 0, 128, B, B + 64 * 256, 256, 256, acc, smem);
      u16* ql = (u16*)(ws + W_QLAT);
      EPI_BEGIN
        ql[(size_t)(rt * 128 + row) * 2048 + ct * 128 + col] = bf1(v * QSCALE);
      EPI_END
    }
  }
  for (int it = 0, nIt = rasterV_iters(130, 4); it < nIt; ++it) {
    int rt, g;
    const bool ok = rasterV(it, 130, 4, rt, g, 3);
    if (!ok) { rt = 0; g = 0; }
    f32x16 acc[2][2];
    zero_acc(acc);
    {
      const u16* A = (const u16*)(ws + W_DB) + (size_t)rt * 128 * 512 + g * 128;
      const u16* B = (const u16*)(ws + W_WPOOLT) + g * 128;
      gemm_main(A, 512, 0, 128, B, B + 64 * 512, 512, 128, acc, smem);
      if (!ok) continue;
      u16* ob = (u16*)(ws + W_OBUF);
      const float* sp = p.in[14];
      EPI_BEGIN
        ob[(size_t)(rt * 128 + row) * 1024 + 512 + g * 128 + col] = bf1(v * sp[g * 128 + col]);
      EPI_END
    }
  }
}

DI bf16x8 pack8(const f32x16& x, int s) {
  uint4 u;
  u.x = pk2(x[8 * s + 0], x[8 * s + 1]); u.y = pk2(x[8 * s + 2], x[8 * s + 3]);
  u.z = pk2(x[8 * s + 4], x[8 * s + 5]); u.w = pk2(x[8 * s + 6], x[8 * s + 7]);
  return __builtin_bit_cast(bf16x8, u);
}

template <int NW>
DI void attn_prompt_item(const Params& p, int qb, int hd, char* smem, int tid) {
  constexpr int NT = 64 * NW, KPT = (768 + NT - 1) / NT, VPT = 512 / NT, CH = NW / 2;
  char* ws = p.ws;
  const int lane = tid & 63, w = tid >> 6, r = lane & 31, h = lane >> 5;
  const u16* qbuf = (const u16*)(ws + W_QBUF);
  const char* Kh = (const char*)((const u16*)(ws + W_KG) + (size_t)hd * TP * 96);
  const u16* Vh = (const u16*)(ws + W_VT) + (size_t)hd * 64 * TP;
  bf16x8 qf[6];
  const size_t qrow = (size_t)qb * (32 * NW) + w * 32 + r;
#pragma unroll
  for (int ks = 0; ks < 6; ++ks) qf[ks] = *(const bf16x8*)(qbuf + qrow * 768 + hd * 96 + ks * 16 + h * 8);
  f32x16 o0, o1, o2;
#pragma unroll
  for (int e = 0; e < 16; ++e) { o0[e] = 0.f; o1[e] = 0.f; o2[e] = 0.f; }
  float m = 0.f;
  f32x16 nm;
#pragma unroll
  for (int e = 0; e < 16; ++e) nm[e] = 0.f;
  bf16x8 ones;
#pragma unroll
  for (int e = 0; e < 8; ++e) ones[e] = (short)0x3F80;
  const int nt = CH * qb + CH, my_nt = CH * qb + 1 + (w >> 1);
  u32x4 rk[KPT], rv[VPT];
#define PA_LOAD(T)                                                                             \
  {                                                                                            \
    const int t_ = (T);                                                                        \
    _Pragma("unroll") for (int i = 0; i < KPT; ++i) {                                          \
      const int c = tid + NT * i, cc = c < 768 ? c : c - 768;                                  \
      rk[i] = *(const u32x4*)(Kh + (size_t)t_ * 64 * 192 + (size_t)cc * 16);                   \
    }                                                                                          \
    _Pragma("unroll") for (int i = 0; i < VPT; ++i) {                                          \
      const int c = tid + NT * i;                                                              \
      rv[i] = *(const u32x4*)(Vh + (size_t)(c >> 3) * TP + t_ * 64 + (c & 7) * 8);             \
    }                                                                                          \
    __builtin_amdgcn_sched_barrier(0);                                                         \
  }
#define PA_WRITE(B)                                                                            \
  {                                                                                            \
    char* kb_ = smem + (B) * 22528;                                                            \
    __builtin_amdgcn_sched_barrier(0);                                                         \
    _Pragma("unroll") for (int i = 0; i < KPT; ++i) {                                          \
      const int c = tid + NT * i;                                                              \
      char* d_ = c < 768 ? kb_ + (c / 12) * 208 + (c % 12) * 16 : smem + 45056 + (c - 768) * 16; \
      *(u32x4*)d_ = rk[i];                                                                     \
    }                                                                                          \
    _Pragma("unroll") for (int i = 0; i < VPT; ++i) {                                          \
      const int c = tid + NT * i;                                                              \
      *(u32x4*)(kb_ + 13312 + (c >> 3) * 144 + (c & 7) * 16) = rv[i];                          \
    }                                                                                          \
    __builtin_amdgcn_sched_barrier(0);                                                         \
  }
  PA_LOAD(0)
  PA_WRITE(0)
  PA_LOAD((1 < nt ? 1 : nt - 1))
  __syncthreads();
  for (int kt = 0; kt < nt; ++kt) {
    const int cur = kt & 1;
    PA_WRITE(cur ^ 1)
    PA_LOAD((kt + 2 < nt ? kt + 2 : nt - 1))
    if (kt < my_nt) {
      const char* Ks = smem + cur * 22528;
      const char* Vs = Ks + 13312;
      f32x16 s0, s1;
      bf16x8 kf0[6], kf1[6];
#pragma unroll
      for (int ks = 0; ks < 6; ++ks) {
        kf0[ks] = *(const bf16x8*)(Ks + r * 208 + ks * 32 + h * 16);
        kf1[ks] = *(const bf16x8*)(Ks + (32 + r) * 208 + ks * 32 + h * 16);
      }
      __builtin_amdgcn_sched_barrier(0);
      s0 = MFMA(kf0[0], qf[0], nm);
      s1 = MFMA(kf1[0], qf[0], nm);
#pragma unroll
      for (int ks = 1; ks < 6; ++ks) {
        s0 = MFMA(kf0[ks], qf[ks], s0);
        s1 = MFMA(kf1[ks], qf[ks], s1);
      }
      bf16x8 vf0[4], vf1[4];
#pragma unroll
      for (int s = 0; s < 4; ++s) {
        vf0[s] = *(const bf16x8*)(Vs + r * 144 + s * 32 + h * 16);
        vf1[s] = *(const bf16x8*)(Vs + (32 + r) * 144 + s * 32 + h * 16);
      }
      __builtin_amdgcn_sched_barrier(0);
      float mx = s0[0];
#pragma unroll
      for (int e = 1; e < 16; ++e) mx = fmaxf(mx, s0[e]);
#pragma unroll
      for (int e = 0; e < 16; ++e) mx = fmaxf(mx, s1[e]);
      mx = half_max(mx);
      if (kt == 0 || __builtin_amdgcn_ballot_w64(mx > 0.f) != 0ull) {
        const float dl = (kt == 0) ? mx : fmaxf(mx, 0.f);
        const float al_ = (kt == 0) ? 1.0f : fexp2(-dl);
        m += dl;
#pragma unroll
        for (int e = 0; e < 16; ++e) { o0[e] *= al_; o1[e] *= al_; s0[e] -= dl; s1[e] -= dl; nm[e] = -m; }
        o2[0] *= al_;
      }
#pragma unroll
      for (int e = 0; e < 16; ++e) s0[e] = fexp2(s0[e]);
#pragma unroll
      for (int e = 0; e < 16; ++e) s1[e] = fexp2(s1[e]);
      bf16x8 pf[4];
      pf[0] = pack8(s0, 0); pf[1] = pack8(s0, 1); pf[2] = pack8(s1, 0); pf[3] = pack8(s1, 1);
#pragma unroll
      for (int s = 0; s < 4; ++s) {
        o0 = MFMA(vf0[s], pf[s], o0);
        o1 = MFMA(vf1[s], pf[s], o1);
        o2 = MFMA(ones, pf[s], o2);
      }
    }
    __syncthreads();
  }
  const float il = __builtin_amdgcn_rcpf(o2[0]);
  u16* ob = (u16*)(ws + W_OBUF) + qrow * 1024 + hd * 64;
#pragma unroll
  for (int g = 0; g < 4; ++g) {
    uint2 a, b;
    a.x = pk2(o0[4 * g] * il, o0[4 * g + 1] * il); a.y = pk2(o0[4 * g + 2] * il, o0[4 * g + 3] * il);
    b.x = pk2(o1[4 * g] * il, o1[4 * g + 1] * il); b.y = pk2(o1[4 * g + 2] * il, o1[4 * g + 3] * il);
    *(uint2*)(ob + 8 * g + 4 * h) = a;
    *(uint2*)(ob + 32 + 8 * g + 4 * h) = b;
  }
}

DI void attn_prompt_item128(const Params& p, int qb, int hd, char* smem, int tid) {
  char* ws = p.ws;
  const int lane = tid & 63, w = tid >> 6, r = lane & 31, h = lane >> 5;
  const u16* qbuf = (const u16*)(ws + W_QBUF);
  const char* Kh = (const char*)((const u16*)(ws + W_KG) + (size_t)hd * TP * 96);
  const u16* Vh = (const u16*)(ws + W_VT) + (size_t)hd * 64 * TP;
  bf16x8 qf[6];
  const size_t qrow = (size_t)qb * 256 + w * 32 + r;
#pragma unroll
  for (int ks = 0; ks < 6; ++ks) qf[ks] = *(const bf16x8*)(qbuf + qrow * 768 + hd * 96 + ks * 16 + h * 8);
  f32x16 o0, o1, o2;
#pragma unroll
  for (int e = 0; e < 16; ++e) { o0[e] = 0.f; o1[e] = 0.f; o2[e] = 0.f; }
  float m = 0.f;
  f32x16 nm;
#pragma unroll
  for (int e = 0; e < 16; ++e) nm[e] = 0.f;
  bf16x8 ones;
#pragma unroll
  for (int e = 0; e < 8; ++e) ones[e] = (short)0x3F80;
  const int nt = 2 * qb + 2, my_n64 = 4 * qb + 1 + (w >> 1);
  u32x4 rk[3], rv[2];
#define PB_LOAD(T)                                                                             \
  {                                                                                            \
    const int t_ = (T);                                                                        \
    _Pragma("unroll") for (int i = 0; i < 3; ++i)                                              \
      rk[i] = *(const u32x4*)(Kh + (size_t)t_ * 128 * 192 + (size_t)(tid + 512 * i) * 16);     \
    _Pragma("unroll") for (int i = 0; i < 2; ++i) {                                            \
      const int c = tid + 512 * i;                                                             \
      rv[i] = *(const u32x4*)(Vh + (size_t)(c >> 4) * TP + t_ * 128 + (c & 15) * 8);           \
    }                                                                                          \
    __builtin_amdgcn_sched_barrier(0);                                                         \
  }
#define PB_WRITE(B)                                                                            \
  {                                                                                            \
    char* kb_ = smem + (B) * 44032;                                                            \
    __builtin_amdgcn_sched_barrier(0);                                                         \
    _Pragma("unroll") for (int i = 0; i < 3; ++i) {                                            \
      const int c = tid + 512 * i;                                                             \
      *(u32x4*)(kb_ + (c / 12) * 208 + (c % 12) * 16) = rk[i];                                 \
    }                                                                                          \
    _Pragma("unroll") for (int i = 0; i < 2; ++i) {                                            \
      const int c = tid + 512 * i;                                                             \
      *(u32x4*)(kb_ + 26624 + (c >> 4) * 272 + (c & 15) * 16) = rv[i];                         \
    }                                                                                          \
    __builtin_amdgcn_sched_barrier(0);                                                         \
  }
#define PB_STEP(KS_, VS_, FIRST)                                                               \
  {                                                                                            \
    const char* Ks = (KS_);                                                                    \
    const char* Vs = (VS_);                                                                    \
    f32x16 s0, s1;                                                                             \
    bf16x8 kf0[6], kf1[6];                                                                     \
    _Pragma("unroll") for (int ks = 0; ks < 6; ++ks) {                                         \
      kf0[ks] = *(const bf16x8*)(Ks + r * 208 + ks * 32 + h * 16);                             \
      kf1[ks] = *(const bf16x8*)(Ks + (32 + r) * 208 + ks * 32 + h * 16);                      \
    }                                                                                          \
    __builtin_amdgcn_sched_barrier(0);                                                         \
    s0 = MFMA(kf0[0], qf[0], nm);                                                              \
    s1 = MFMA(kf1[0], qf[0], nm);                                                              \
    _Pragma("unroll") for (int ks = 1; ks < 6; ++ks) {                                         \
      s0 = MFMA(kf0[ks], qf[ks], s0);                                                          \
      s1 = MFMA(kf1[ks], qf[ks], s1);                                                          \
    }                                                                                          \
    bf16x8 vf0[4], vf1[4];                                                                     \
    _Pragma("unroll") for (int s = 0; s < 4; ++s) {                                            \
      vf0[s] = *(const bf16x8*)(Vs + r * 272 + s * 32 + h * 16);                               \
      vf1[s] = *(const bf16x8*)(Vs + (32 + r) * 272 + s * 32 + h * 16);                        \
    }                                                                                          \
    __builtin_amdgcn_sched_barrier(0);                                                         \
    float mx = s0[0];                                                                          \
    _Pragma("unroll") for (int e = 1; e < 16; ++e) mx = fmaxf(mx, s0[e]);                      \
    _Pragma("unroll") for (int e = 0; e < 16; ++e) mx = fmaxf(mx, s1[e]);                      \
    mx = half_max(mx);                                                                         \
    if ((FIRST) || __builtin_amdgcn_ballot_w64(mx > 0.f) != 0ull) {                            \
      const float dl = (FIRST) ? mx : fmaxf(mx, 0.f);                                          \
      const float al_ = (FIRST) ? 1.0f : fexp2(-dl);                                           \
      m += dl;                                                                                 \
      _Pragma("unroll") for (int e = 0; e < 16; ++e) { o0[e] *= al_; o1[e] *= al_; s0[e] -= dl; s1[e] -= dl; nm[e] = -m; } \
      o2[0] *= al_;                                                                            \
    }                                                                                          \
    _Pragma("unroll") for (int e = 0; e < 16; ++e) s0[e] = fexp2(s0[e]);                       \
    _Pragma("unroll") for (int e = 0; e < 16; ++e) s1[e] = fexp2(s1[e]);                       \
    bf16x8 pf[4];                                                                              \
    pf[0] = pack8(s0, 0); pf[1] = pack8(s0, 1); pf[2] = pack8(s1, 0); pf[3] = pack8(s1, 1);    \
    _Pragma("unroll") for (int s = 0; s < 4; ++s) {                                            \
      o0 = MFMA(vf0[s], pf[s], o0);                                                            \
      o1 = MFMA(vf1[s], pf[s], o1);                                                            \
      o2 = MFMA(ones, pf[s], o2);                                                              \
    }                                                                                          \
  }
  PB_LOAD(0)
  PB_WRITE(0)
  PB_LOAD((1 < nt ? 1 : nt - 1))
  __syncthreads();
  for (int kt = 0; kt < nt; ++kt) {
    const int cur = kt & 1;
    PB_WRITE(cur ^ 1)
    PB_LOAD((kt + 2 < nt ? kt + 2 : nt - 1))
    const char* kb = smem + cur * 44032;
    if (2 * kt < my_n64) PB_STEP(kb, kb + 26624, (kt == 0))
    if (2 * kt + 1 < my_n64) PB_STEP(kb + 64 * 208, kb + 26624 + 128, false)
    __syncthreads();
  }
  const float il = __builtin_amdgcn_rcpf(o2[0]);
  u16* ob = (u16*)(ws + W_OBUF) + qrow * 1024 + hd * 64;
#pragma unroll
  for (int g = 0; g < 4; ++g) {
    uint2 a, b;
    a.x = pk2(o0[4 * g] * il, o0[4 * g + 1] * il); a.y = pk2(o0[4 * g + 2] * il, o0[4 * g + 3] * il);
    b.x = pk2(o1[4 * g] * il, o1[4 * g + 1] * il); b.y = pk2(o1[4 * g + 2] * il, o1[4 * g + 3] * il);
    *(uint2*)(ob + 8 * g + 4 * h) = a;
    *(uint2*)(ob + 32 + 8 * g + 4 * h) = b;
  }
}

DI void attn_sample_item(const Params& p, int b, int hh, int sp, char* smem) {
  char* ws = p.ws;
  const int tid = TIDX, lane = tid & 63, w = tid >> 6, r = lane & 31, h = lane >> 5;
  const int rgp = w & 1, dvh = w >> 1;
  char* Qs = smem + 32 * 592;
  __syncthreads();
  for (int c = tid; c < 64 * 36; c += 256) {
    const int rw = c / 36, part = c % 36;
    const int hq = 4 * hh + (rw >> 4);
    const size_t sr_ = (size_t)b * 16 + (rw & 15);
    const u16* src = part < 32 ? (const u16*)(ws + W_QLAT) + sr_ * 2048 + hq * 256 + part * 8
                               : (const u16*)(ws + W_QBUF) + ((size_t)TP + sr_) * 768 + hq * 96 + 64 + (part - 32) * 8;
    *(uint4*)(Qs + rw * 592 + part * 16) = *(const uint4*)src;
  }
  f32x16 o[4];
#pragma unroll
  for (int i = 0; i < 4; ++i)
#pragma unroll
    for (int e = 0; e < 16; ++e) o[i][e] = 0.f;
  float m = -1e30f, l = 0.f;
  const int t0 = 33 * sp, t1 = (33 * sp + 33 < 129) ? 33 * sp + 33 : 129;
  const float* cc = p.in[2] + (size_t)b * 4096 * 256;
  const float* ck = p.in[3] + (size_t)b * 4096 * 32;
  const float* nc = p.out + O_CKVS + (size_t)b * 16 * 256;
  const float* nk = p.out + O_KRS + (size_t)b * 16 * 32;
  char* Ks = smem;
  f32x4 rc[8], rr;
#define SAMPLE_LOAD_TILE(KT)                                                                   \
  {                                                                                            \
    _Pragma("unroll") for (int i = 0; i < 8; ++i) {                                            \
      const int c = tid + 256 * i, key = c >> 6, part = c & 63, gk = (KT) * 32 + key;          \
      if (gk < 4096) rc[i] = __builtin_nontemporal_load((const f32x4*)(cc + (size_t)gk * 256) + part);                \
      else if (gk < 4112) rc[i] = ((const f32x4*)(nc + (size_t)(gk - 4096) * 256))[part];     \
      else rc[i] = (f32x4){0.f, 0.f, 0.f, 0.f};                                            \
    }                                                                                          \
    {                                                                                          \
      const int key = tid >> 3, part = tid & 7, gk = (KT) * 32 + key;                          \
      if (gk < 4096) rr = __builtin_nontemporal_load((const f32x4*)(ck + (size_t)gk * 32) + part);                   \
      else if (gk < 4112) rr = ((const f32x4*)(nk + (size_t)(gk - 4096) * 32))[part];         \
      else rr = (f32x4){0.f, 0.f, 0.f, 0.f};                                               \
    }                                                                                          \
  }
  SAMPLE_LOAD_TILE(t0)
  const int i16 = lane & 15, tq_ = i16 >> 2, tp_ = i16 & 3, blk = (lane >> 4) & 1;
  for (int kt = t0; kt < t1; ++kt) {
    __syncthreads();
#pragma unroll
    for (int i = 0; i < 8; ++i) {
      const int c = tid + 256 * i, key = c >> 6, part = c & 63;
      uint2 u; u.x = pk2(rc[i].x, rc[i].y); u.y = pk2(rc[i].z, rc[i].w);
      *(uint2*)(Ks + key * 592 + part * 8) = u;
    }
    {
      const int key = tid >> 3, part = tid & 7;
      uint2 u; u.x = pk2(rr.x, rr.y); u.y = pk2(rr.z, rr.w);
      *(uint2*)(Ks + key * 592 + 512 + part * 8) = u;
    }
    __syncthreads();
    if (kt + 1 < t1) SAMPLE_LOAD_TILE(kt + 1)
    f32x16 s;
#pragma unroll
    for (int e = 0; e < 16; ++e) s[e] = 0.f;
#pragma unroll
    for (int ks = 0; ks < 18; ++ks) {
      const bf16x8 kf = *(const bf16x8*)(Ks + r * 592 + ks * 32 + h * 16);
      const bf16x8 qv = *(const bf16x8*)(Qs + (32 * rgp + r) * 592 + ks * 32 + h * 16);
      s = MFMA(kf, qv, s);
    }
    const int kbase = kt * 32 + 4 * h;
#pragma unroll
    for (int e = 0; e < 16; ++e) {
      const int gk = kbase + (e & 3) + 8 * (e >> 2);
      if (gk >= 4112) s[e] = -1e30f;
    }
    float mx = s[0];
#pragma unroll
    for (int e = 1; e < 16; ++e) mx = fmaxf(mx, s[e]);
    mx = half_max(mx);
    const float mn = fmaxf(m, mx);
    const float al_ = fexp2(m - mn);
    m = mn;
    float ls = 0.f;
#pragma unroll
    for (int e = 0; e < 16; ++e) { s[e] = fexp2(s[e] - mn); ls += s[e]; }
    l = l * al_ + ls;
#pragma unroll
    for (int i = 0; i < 4; ++i)
#pragma unroll
      for (int e = 0; e < 16; ++e) o[i][e] *= al_;
    bf16x8 pf[2];
    pf[0] = pack8(s, 0); pf[1] = pack8(s, 1);
#pragma unroll
    for (int nd = 0; nd < 4; ++nd) {
      const int dv0 = 128 * dvh + 32 * nd;
#pragma unroll
      for (int s2 = 0; s2 < 2; ++s2) {
        const char* a0 = Ks + (16 * s2 + 4 * h + tq_) * 592 + (dv0 + 16 * blk) * 2 + 8 * tp_;
        const s16x4 lo = __builtin_amdgcn_ds_read_tr16_b64_v4i16(LDS3(s16x4, a0));
        const s16x4 hi = __builtin_amdgcn_ds_read_tr16_b64_v4i16(LDS3(s16x4, a0 + 8 * 592));
        const bf16x8 vf = __builtin_shufflevector(lo, hi, 0, 1, 2, 3, 4, 5, 6, 7);
        o[nd] = MFMA(vf, pf[s2], o[nd]);
      }
    }
  }
  l = half_sum(l);
  const int row128 = (4 * hh + 2 * rgp) * 16 + r;
  const size_t pbase = ((size_t)(b * NSP + sp) * 128 + row128);
  float* op = (float*)(ws + W_OPART) + pbase * 256;
#pragma unroll
  for (int nd = 0; nd < 4; ++nd)
#pragma unroll
    for (int g = 0; g < 4; ++g) {
      float4 v; v.x = o[nd][4 * g]; v.y = o[nd][4 * g + 1]; v.z = o[nd][4 * g + 2]; v.w = o[nd][4 * g + 3];
      *(float4*)(op + 128 * dvh + 32 * nd + 8 * g + 4 * h) = v;
    }
  if (dvh == 0 && h == 0) {
    float* ml = (float*)(ws + W_ML) + pbase * 2;
    ml[0] = m; ml[1] = l;
  }
  __syncthreads();
}

DI void combine_batch(const Params& p, char* smem, int bsel) {
  char* ws = p.ws;
  float* sl = (float*)smem;
  float* sr = (float*)smem + 4096;
  const int tid = TIDX;
  const float* wkv = p.in[12];
  const float* ml = (const float*)(ws + W_ML);
  const float* op = (const float*)(ws + W_OPART);
  for (int i0 = 0; i0 < 8; i0 += 2) {
    const int hd = i0 + HB;
#pragma unroll 4
    for (int tq = 0; tq < 16; ++tq) {
      const int row128 = hd * 16 + tq;
      float ms[NSP], ls[NSP], M = -1e30f;
#pragma unroll
      for (int s2 = 0; s2 < NSP; ++s2) {
        const size_t pb = ((size_t)(bsel * NSP + s2) * 128 + row128);
        ms[s2] = ml[pb * 2]; ls[s2] = ml[pb * 2 + 1];
        M = fmaxf(M, ms[s2]);
      }
      float L = 0.f, a = 0.f;
#pragma unroll
      for (int s2 = 0; s2 < NSP; ++s2) {
        const size_t pb = ((size_t)(bsel * NSP + s2) * 128 + row128);
        const float wgt = fexp2(ms[s2] - M);
        L += wgt * ls[s2];
        a += wgt * op[pb * 256 + tid];
      }
      sl[tq * 256 + tid] = a * __builtin_amdgcn_rcpf(L);
    }
    __syncthreads();
    const int vv = tid & 63, part = tid >> 6;
    float acc[16];
#pragma unroll
    for (int tq = 0; tq < 16; ++tq) acc[tq] = 0.f;
#pragma unroll 4
    for (int i = 0; i < 64; ++i) {
      const int li = part * 64 + i;
      const float wv = wkv[(size_t)li * 1024 + hd * 128 + 64 + vv];
#pragma unroll
      for (int tq = 0; tq < 16; ++tq) acc[tq] += wv * sl[tq * 256 + li];
    }
#pragma unroll
    for (int tq = 0; tq < 16; ++tq) sr[(part * 16 + tq) * 64 + vv] = acc[tq];
    __syncthreads();
#pragma unroll
    for (int k = 0; k < 4; ++k) {
      const int o = tid + 256 * k, tq = o >> 6, v = o & 63;
      const float r4 = sr[(0 * 16 + tq) * 64 + v] + sr[(1 * 16 + tq) * 64 + v] + sr[(2 * 16 + tq) * 64 + v] + sr[(3 * 16 + tq) * 64 + v];
      ((u16*)(ws + W_OBUF))[((size_t)TP + bsel * 16 + tq) * 1024 + hd * 64 + v] = bf1(r4);
    }
    __syncthreads();
  }
}

DI void phase4(const Params& p, char* smem, int* s_item) {
  char* hs = smem + HB * HALF_BYTES;
  int* cnt = (int*)(p.ws + W_CNT);
  const int NSI = 16 * NSP, NITEM = NSI + 512;
  for (;;) {
    if (threadIdx.x == 0) *s_item = atomicAdd(cnt, 1);
    __syncthreads();
    const int it = *s_item;
    __syncthreads();
    if (it >= NITEM) break;
    if (it < NSI) {
      const int bsel = it / NSP;
      attn_sample_item(p, bsel, HB, it % NSP, hs);
      asm volatile("s_waitcnt vmcnt(0)" ::: "memory");
      __syncthreads();
      if (threadIdx.x == 0) {
        __builtin_amdgcn_fence(__ATOMIC_RELEASE, "agent");
        asm volatile("s_waitcnt vmcnt(0)" ::: "memory");
        const int old = __hip_atomic_fetch_add(cnt + 16 + bsel, 1, __ATOMIC_RELAXED, __HIP_MEMORY_SCOPE_AGENT);
        const int last = (old == NSP - 1) ? 1 : 0;
        if (last) {
          __builtin_amdgcn_fence(__ATOMIC_ACQUIRE, "agent");
          asm volatile("s_waitcnt vmcnt(0)" ::: "memory");
        }
        *s_item = last;
      }
      __syncthreads();
      const int last = *s_item;
      __syncthreads();
      if (last) combine_batch(p, hs, bsel);
    } else {
      const int q = it - NSI;
      attn_prompt_item128(p, 63 - (q >> 3), q & 7, smem, TID8);
    }
  }
}

DI void phase5(const Params& p, char* smem) {
  char* ws = p.ws;
  char* hs = smem + HB * HALF_BYTES;
  for (int t = blockIdx.x; t < 256; t += gridDim.x) {
    int rt, ct;
    tile256(t, rt, ct);
    f32x16 acc[4][2];
    zero_acc8(acc);
    const u16* A = (const u16*)(ws + W_OBUF) + (size_t)rt * 256 * 1024;
    const u16* B = (const u16*)(ws + W_WOT) + (size_t)ct * 256 * 1024;
    gemm256(A, 1024, 0, 256, B, B + 128 * 1024, 1024, 1024, acc, smem);
    const float* xs = p.in[0] + (size_t)rt * 256 * 1024;
    float* y = p.out + O_Y + (size_t)rt * 256 * 1024;
    {
      const int t8 = TID8, lane = t8 & 63, wave = t8 >> 6, wm = wave >> 2, wn = wave & 3, r = lane & 31, h = lane >> 5;
      const size_t off = (size_t)(wm * 128 + 4 * h) * 1024 + ct * 256 + wn * 64 + r;
      const float* __restrict__ xs_ = xs + off;
      float* __restrict__ y_ = y + off;
#pragma unroll
      for (int mi = 0; mi < 4; ++mi)
#pragma unroll
        for (int ni = 0; ni < 2; ++ni) {
          float xv[16];
#pragma unroll
          for (int reg = 0; reg < 16; ++reg) xv[reg] = __builtin_nontemporal_load(&xs_[(size_t)(mi * 32 + (reg & 3) + 8 * (reg >> 2)) * 1024 + ni * 32]);
#pragma unroll
          for (int reg = 0; reg < 16; ++reg) y_[(size_t)(mi * 32 + (reg & 3) + 8 * (reg >> 2)) * 1024 + ni * 32] = ALPHA_F * xv[reg] + acc[mi][ni][reg];
        }
    }
  }
  for (int q = blockIdx.x; q < 256; q += gridDim.x) {
    const int r0 = (q >> 5) * 32, c0 = (q & 31) * 32;
    const f32x16 c = small_gemm32w8((const u16*)(ws + W_OBUF) + (size_t)(TP + r0) * 1024, 1024, (const u16*)(ws + W_WOT) + (size_t)c0 * 1024, 1024, 1024, smem);
    const float* xs = p.in[1];
    float* y = p.out + O_Y + (size_t)TP * 1024;
    if ((TID8 >> 6) == 0) {
      const int lane = TID8 & 63, rr = lane & 31, hh = lane >> 5;
      float xv[16];
#pragma unroll
      for (int reg = 0; reg < 16; ++reg) xv[reg] = __builtin_nontemporal_load(&xs[(size_t)(r0 + (reg & 3) + 8 * (reg >> 2) + 4 * hh) * 1024 + c0 + rr]);
#pragma unroll
      for (int reg = 0; reg < 16; ++reg) y[(size_t)(r0 + (reg & 3) + 8 * (reg >> 2) + 4 * hh) * 1024 + c0 + rr] = ALPHA_F * xv[reg] + c[reg];
    }
  }
}

DI void phase_ln(const Params& p, const float* __restrict__ g, const float* __restrict__ bta, u16* bcopy) {
  const int lane = TIDX & 63;
  const int gw = VB * 4 + (TIDX >> 6), nw = VG * 4;
  float4 gg[4], bb[4];
#pragma unroll
  for (int i = 0; i < 4; ++i) { gg[i] = ((const float4*)g)[lane + 64 * i]; bb[i] = ((const float4*)bta)[lane + 64 * i]; }
  for (int row = gw; row < TT; row += nw) {
    float4* y = (float4*)(p.out + O_Y + (size_t)row * 1024);
    float4 v[4];
    float s = 0.f;
#pragma unroll
    for (int i = 0; i < 4; ++i) { v[i] = y[lane + 64 * i]; s += v[i].x + v[i].y + v[i].z + v[i].w; }
    const float mu = wave_sum(s) * (1.0f / 1024.0f);
    float q = 0.f;
#pragma unroll
    for (int i = 0; i < 4; ++i) {
      v[i].x -= mu; v[i].y -= mu; v[i].z -= mu; v[i].w -= mu;
      q += v[i].x * v[i].x + v[i].y * v[i].y + v[i].z * v[i].z + v[i].w * v[i].w;
    }
    const float rs = rsqrtf(wave_sum(q) * (1.0f / 1024.0f) + 1e-5f);
#pragma unroll
    for (int i = 0; i < 4; ++i) {
      float4 o;
      o.x = v[i].x * rs * gg[i].x + bb[i].x; o.y = v[i].y * rs * gg[i].y + bb[i].y;
      o.z = v[i].z * rs * gg[i].z + bb[i].z; o.w = v[i].w * rs * gg[i].w + bb[i].w;
      if (!bcopy) y[lane + 64 * i] = o;
      if (bcopy) {
        uint2 u; u.x = pk2(o.x, o.y); u.y = pk2(o.z, o.w);
        ((uint2*)(bcopy + (size_t)row * 1024))[lane + 64 * i] = u;
      }
    }
  }
}

DI void phase7(const Params& p, char* smem) {
  char* ws = p.ws;
  char* hs = smem + HB * HALF_BYTES;
  const float* wdw = p.in[19];
  const float* bdw = p.in[20];
  const float* hist = p.in[5];
  for (int it = 0;; ++it) {
    const int b = blockIdx.x, per = gridDim.x >> 3;
    const int ord = (it * 8 + (b & 7)) * per + (b >> 3);
    if (ord >= 66 * 22) break;
    int ri, jt;
    if (ord < 64 * 22) { const int sr = ord / 176, rem = ord - sr * 176; jt = rem >> 3; ri = sr * 8 + (rem & 7); }
    else { const int o = ord - 64 * 22; ri = 64 + (o & 1); jt = o >> 1; }
    f32x16 acc[4][2];
    zero_acc8(acc);
    const bool samp = ri == 65;
    const int r0 = samp ? TP : 254 * ri - 2;
    int rlo = 0, rhi = 256;
    if (!samp) { if (r0 < 0) rlo = -r0; if (r0 + 256 > TP) rhi = TP - r0; }
    const int j0 = jt * 128;
    const u16* A = (const u16*)(ws + W_X1B) + (ptrdiff_t)r0 * 1024;
    const u16* B0 = (const u16*)(ws + W_WUPT) + (size_t)j0 * 1024;
    const u16* B1 = (const u16*)(ws + W_WUPT) + (size_t)(DFF + j0) * 1024;
    gemm256<true>(A, 1024, rlo, rhi, B0, B1, 1024, 1024, acc, smem);
    {
      const int t8 = TID8, lane = t8 & 63, wave = t8 >> 6, wm = wave >> 2, wn = wave & 3, r = lane & 31, h = lane >> 5;
      const int jp = t8 & 63, rgp = t8 >> 6;
      const int ca_ = j0 + 2 * jp, cb_ = DFF + j0 + 2 * jp;
      const float2 w0a = *(const float2*)(wdw + ca_), w1a = *(const float2*)(wdw + DFF2 + ca_), w2a = *(const float2*)(wdw + 2 * DFF2 + ca_), ba = *(const float2*)(bdw + ca_);
      const float2 w0b = *(const float2*)(wdw + cb_), w1b = *(const float2*)(wdw + DFF2 + cb_), w2b = *(const float2*)(wdw + 2 * DFF2 + cb_), bb2 = *(const float2*)(bdw + cb_);
      u16* act = (u16*)(ws + W_ACT);
#pragma unroll
      for (int c = 0; c < 4; ++c) {
        float* Uc = (float*)(smem + (c & 1) * 67584);
        const float* Up = (const float*)(smem + ((c & 1) ^ 1) * 67584);
        if (wm == (c >> 1)) {
#pragma unroll
          for (int mm = 0; mm < 2; ++mm)
#pragma unroll
            for (int ni = 0; ni < 2; ++ni)
#pragma unroll
              for (int reg = 0; reg < 16; ++reg)
                Uc[(mm * 32 + (reg & 3) + 8 * (reg >> 2) + 4 * h) * 264 + wn * 64 + ni * 32 + r] = acc[2 * (c & 1) + mm][ni][reg];
        }
        __syncthreads();
        {
          const int lr0 = rgp * 8, trow0 = 64 * c + lr0;
          int lbeg = lr0;
          const float* Ua = Uc + 2 * jp;
          float2 u0a, u0b, u1a, u1b;
          if (samp && (trow0 & 15) == 0) {
            const float* hb = hist + (size_t)(trow0 >> 4) * 2 * DFF2;
            u0a = *(const float2*)(hb + ca_); u0b = *(const float2*)(hb + cb_);
            u1a = *(const float2*)(hb + DFF2 + ca_); u1b = *(const float2*)(hb + DFF2 + cb_);
          } else if (lr0 == 0) {
            if (c == 0) {
              lbeg = 2;
              u0a = *(const float2*)(Ua); u0b = *(const float2*)(Ua + 128);
              u1a = *(const float2*)(Ua + 264); u1b = *(const float2*)(Ua + 264 + 128);
            } else {
              u0a = *(const float2*)(Up + 62 * 264 + 2 * jp); u0b = *(const float2*)(Up + 62 * 264 + 2 * jp + 128);
              u1a = *(const float2*)(Up + 63 * 264 + 2 * jp); u1b = *(const float2*)(Up + 63 * 264 + 2 * jp + 128);
            }
          } else {
            u0a = *(const float2*)(Ua + (lr0 - 2) * 264); u0b = *(const float2*)(Ua + (lr0 - 2) * 264 + 128);
            u1a = *(const float2*)(Ua + (lr0 - 1) * 264); u1b = *(const float2*)(Ua + (lr0 - 1) * 264 + 128);
          }
          for (int lr = lbeg; lr < lr0 + 8; ++lr) {
            const int trow = 64 * c + lr, grow = r0 + trow;
            const float2 u2a = *(const float2*)(Ua + lr * 264), u2b = *(const float2*)(Ua + lr * 264 + 128);
            if (samp || grow < TP) {
              const float cax = w0a.x * u0a.x + w1a.x * u1a.x + w2a.x * u2a.x + ba.x;
              const float cay = w0a.y * u0a.y + w1a.y * u1a.y + w2a.y * u2a.y + ba.y;
              const float cbx = w0b.x * u0b.x + w1b.x * u1b.x + w2b.x * u2b.x + bb2.x;
              const float cby = w0b.y * u0b.y + w1b.y * u1b.y + w2b.y * u2b.y + bb2.y;
              const float sx = cax * __builtin_amdgcn_rcpf(1.0f + __expf(-cax));
              const float sy = cay * __builtin_amdgcn_rcpf(1.0f + __expf(-cay));
              *(unsigned*)(act + (size_t)grow * DFF + ca_) = pk2(sx * cbx, sy * cby);
              const bool st_p = !samp && grow >= TP - 2;
              const bool st_s = samp && (trow & 15) >= 14;
              if (st_p || st_s) {
                float* cp = st_p ? p.out + O_CONVP + (size_t)(grow - (TP - 2)) * DFF2
                                 : p.out + O_CONVS + ((size_t)(trow >> 4) * 2 + ((trow & 15) - 14)) * DFF2;
                *(float2*)(cp + ca_) = u2a; *(float2*)(cp + cb_) = u2b;
              }
            }
            u0a = u1a; u0b = u1b; u1a = u2a; u1b = u2b;
          }
        }
        __syncthreads();
      }
    }
  }
  const int lrk = 32 * (int)(blockIdx.x & 7) + (int)(blockIdx.x >> 3) - 172;
  const bool lgt = gridDim.x == 256;
  for (int q = lgt ? (lrk >= 0 ? lrk : 256) : (int)blockIdx.x; q < 256; q += lgt ? 84 : (int)gridDim.x) {
    const int r0 = (q >> 5) * 32, c0 = (q & 31) * 32;
    const f32x16 g = small_gemm32w8((const u16*)(ws + W_X1B) + (size_t)(TP + r0) * 1024, 1024, (const u16*)(ws + W_WPGT) + (size_t)c0 * 1024, 1024, 1024, smem);
    const f32x16 e = small_gemm32w8((const u16*)(ws + W_PEB) + (size_t)(TP + r0) * 256, 256, (const u16*)(ws + W_WPET) + (size_t)c0 * 256, 256, 256, smem);
    u16* ple = (u16*)(ws + W_PLE) + (size_t)TP * 1024;
    SMALL8_EPI_BEGIN(e)
      ple[(size_t)(r0 + row) * 1024 + c0 + col] = bf1(v * __builtin_amdgcn_rcpf(1.0f + __expf(-g[reg])));
    SMALL_EPI_END
  }
  for (int t = blockIdx.x; t < 256; t += gridDim.x) {
    int rt, ct;
    tile256(t, rt, ct);
    f32x16 acc[4][2];
    zero_acc8(acc);
    u16* ple = (u16*)(ws + W_PLE) + (size_t)rt * 256 * 1024 + ct * 256;
    const u16* A2 = (const u16*)(ws + W_X1B) + (size_t)rt * 256 * 1024;
    const u16* Bg = (const u16*)(ws + W_WPGT) + (size_t)ct * 256 * 1024;
    gemm256(A2, 1024, 0, 256, Bg, Bg + 128 * 1024, 1024, 1024, acc, smem);
    EPI256_BEGIN
      ple[(size_t)row * 1024 + col] = bf1(__builtin_amdgcn_rcpf(1.0f + __expf(-v)));
    EPI256_END
    zero_acc8(acc);
    const u16* A1 = (const u16*)(ws + W_PEB) + (size_t)rt * 256 * 256;
    const u16* Bp = (const u16*)(ws + W_WPET) + (size_t)ct * 256 * 256;
    gemm256(A1, 256, 0, 256, Bp, Bp + 128 * 256, 256, 256, acc, smem);
    {
      const int t8 = TID8, lane = t8 & 63, wave = t8 >> 6, wm = wave >> 2, wn = wave & 3, r = lane & 31, h = lane >> 5;
      u16* pp = ple + (size_t)(wm * 128 + 4 * h) * 1024 + wn * 64 + r;
#pragma unroll
      for (int mi = 0; mi < 4; ++mi)
#pragma unroll
        for (int ni = 0; ni < 2; ++ni) {
          float gv[16];
#pragma unroll
          for (int reg = 0; reg < 16; ++reg) gv[reg] = bf2f(pp[(size_t)(mi * 32 + (reg & 3) + 8 * (reg >> 2)) * 1024 + ni * 32]);
#pragma unroll
          for (int reg = 0; reg < 16; ++reg) pp[(size_t)(mi * 32 + (reg & 3) + 8 * (reg >> 2)) * 1024 + ni * 32] = bf1(acc[mi][ni][reg] * gv[reg]);
        }
    }
  }
}

DI void phase9(const Params& p, char* smem) {
  char* ws = p.ws;
  char* hs = smem + HB * HALF_BYTES;
  for (int t = blockIdx.x; t < 256; t += gridDim.x) {
    int rt, ct;
    tile256(t, rt, ct);
    f32x16 acc[4][2];
    zero_acc8(acc);
    const u16* A = (const u16*)(ws + W_ACT) + (size_t)rt * 256 * DFF;
    const u16* B = (const u16*)(ws + W_WDOWNT) + (size_t)ct * 256 * DFF;
    gemm256(A, DFF, 0, 256, B, B + 128 * DFF, DFF, DFF, acc, smem);
    float* y = p.out + O_Y + (size_t)rt * 256 * 1024;
    const u16* ple = (const u16*)(ws + W_PLE) + (size_t)rt * 256 * 1024;
    {
      const int t8 = TID8, lane = t8 & 63, wave = t8 >> 6, wm = wave >> 2, wn = wave & 3, r = lane & 31, h = lane >> 5;
      const size_t off = (size_t)(wm * 128 + 4 * h) * 1024 + ct * 256 + wn * 64 + r;
      float* __restrict__ y_ = y + off;
      const u16* __restrict__ pl_ = ple + off;
      const u16* __restrict__ x1_ = (const u16*)(ws + W_X1B) + (size_t)rt * 256 * 1024 + off;
#pragma unroll
      for (int mi = 0; mi < 4; ++mi)
#pragma unroll
        for (int ni = 0; ni < 2; ++ni) {
          float yv[16], pv[16];
#pragma unroll
          for (int reg = 0; reg < 16; ++reg) {
            const size_t o = (size_t)(mi * 32 + (reg & 3) + 8 * (reg >> 2)) * 1024 + ni * 32;
            yv[reg] = bf2f(x1_[o]); pv[reg] = bf2f(pl_[o]);
          }
#pragma unroll
          for (int reg = 0; reg < 16; ++reg) {
            const size_t o = (size_t)(mi * 32 + (reg & 3) + 8 * (reg >> 2)) * 1024 + ni * 32;
            y_[o] = ALPHA_F * yv[reg] + acc[mi][ni][reg] + pv[reg];
          }
        }
    }
  }
  for (int q = blockIdx.x; q < 256; q += gridDim.x) {
    const int r0 = (q >> 5) * 32, c0 = (q & 31) * 32;
    const f32x16 c = small_gemm32w8((const u16*)(ws + W_ACT) + (size_t)(TP + r0) * DFF, DFF, (const u16*)(ws + W_WDOWNT) + (size_t)c0 * DFF, DFF, DFF, smem);
    float* y = p.out + O_Y + (size_t)TP * 1024;
    const u16* ple = (const u16*)(ws + W_PLE) + (size_t)TP * 1024;
    if ((TID8 >> 6) == 0) {
      const int lane = TID8 & 63, rr = lane & 31, hh = lane >> 5;
      float yv[16], pv[16];
#pragma unroll
      for (int reg = 0; reg < 16; ++reg) {
        const size_t o = (size_t)(r0 + (reg & 3) + 8 * (reg >> 2) + 4 * hh) * 1024 + c0 + rr;
        yv[reg] = bf2f(((const u16*)(ws + W_X1B) + (size_t)TP * 1024)[o]); pv[reg] = bf2f(ple[o]);
      }
#pragma unroll
      for (int reg = 0; reg < 16; ++reg) {
        const size_t o = (size_t)(r0 + (reg & 3) + 8 * (reg >> 2) + 4 * hh) * 1024 + c0 + rr;
        y[o] = ALPHA_F * yv[reg] + c[reg] + pv[reg];
      }
    }
  }
}

#define XB_TMO      128
#define XB_XCNT(j)  (256  + 64 * (j))
#define XB_XSUB(j)  (1280 + 64 * (j))
#define XB_XGEN(j)  (2304 + 64 * (j))
#define XB_TOP      3328
#define XB_TOPGEN   3392
#define XCD_BAR_WORDS 3456
#define XB_SPIN_CAP (1u << 20)
#define LAS __attribute__((address_space(3)))
DI unsigned xb_ld(unsigned* p) { return __hip_atomic_load(p, __ATOMIC_RELAXED, __HIP_MEMORY_SCOPE_AGENT); }
DI unsigned xb_add(unsigned* p, unsigned v) { return __hip_atomic_fetch_add(p, v, __ATOMIC_RELAXED, __HIP_MEMORY_SCOPE_AGENT); }
DI unsigned xb_xcc_id() { return (unsigned)__builtin_amdgcn_s_getreg((3 << 11) | 20) & 0xFu; }
#define XB_SPIN(cond, bar) do { unsigned _sp = 0; while (cond) { __builtin_amdgcn_s_sleep(1); \
    if ((++_sp & 255u) == 0u) { if (xb_ld(&(bar)[XB_TMO])) break; if (_sp > XB_SPIN_CAP) { atomicAdd(&(bar)[XB_TMO], 1u); break; } } } } while (0)
struct XcdBarrier { unsigned* bar; unsigned x; volatile LAS unsigned* st; };
DI XcdBarrier xcd_barrier_post(unsigned* bar, volatile LAS unsigned* st) {
  XcdBarrier b; b.bar = bar; b.x = xb_xcc_id(); b.st = st;
  if (threadIdx.x == 0) (void)xb_add(&bar[XB_XCNT(b.x)], 1u);
  return b;
}
DI void xcd_barrier_complete(unsigned* bar, unsigned x, unsigned& nloc, unsigned& nx) {
  const unsigned G = gridDim.x;
  unsigned sum, cnt, mine, sp = 0u;
  for (;;) {
    sum = 0u; cnt = 0u; mine = 0u;
#pragma unroll
    for (unsigned j = 0; j < 16; ++j) { const unsigned c = xb_ld(&bar[XB_XCNT(j)]); sum += c; cnt += (c > 0u) ? 1u : 0u; mine = (j == x) ? c : mine; }
    if (sum == G) break;
    __builtin_amdgcn_s_sleep(1);
    if ((++sp & 255u) == 0u) { if (xb_ld(&bar[XB_TMO])) break; if (sp > XB_SPIN_CAP) { atomicAdd(&bar[XB_TMO], 1u); break; } }
  }
  nloc = mine > 0u ? mine : 1u; nx = cnt > 0u ? cnt : 1u;
}
DI void xcd_barrier(const XcdBarrier& b) {
  asm volatile("s_waitcnt vmcnt(0)" ::: "memory");
  __syncthreads();
  if (threadIdx.x == 0) {
    unsigned* bar = b.bar;
    __builtin_amdgcn_s_waitcnt(0);
    unsigned nloc = b.st[0], nx = b.st[1];
    if (nloc == 0u) { xcd_barrier_complete(bar, b.x, nloc, nx); b.st[0] = nloc; b.st[1] = nx; }
    const unsigned old = xb_add(&bar[XB_XSUB(b.x)], 1u);
    const unsigned gen = old / nloc;
    if (old + 1u == (gen + 1u) * nloc) {
      __builtin_amdgcn_fence(__ATOMIC_RELEASE, "agent");
      asm volatile("s_waitcnt vmcnt(0)" ::: "memory");
      const unsigned og = xb_add(&bar[XB_TOP], 1u);
      const unsigned tg = og / nx;
      if (og + 1u == (tg + 1u) * nx) xb_add(&bar[XB_TOPGEN], 1u);
      else XB_SPIN(xb_ld(&bar[XB_TOPGEN]) == tg, bar);
      __builtin_amdgcn_fence(__ATOMIC_ACQUIRE, "agent");
      xb_add(&bar[XB_XGEN(b.x)], 1u);
      asm volatile("s_waitcnt vmcnt(0)" ::: "memory");
    } else {
      XB_SPIN(xb_ld(&bar[XB_XGEN(b.x)]) == gen, bar);
      __builtin_amdgcn_fence(__ATOMIC_ACQUIRE, "agent");
      asm volatile("s_waitcnt vmcnt(0)" ::: "memory");
    }
  }
  __syncthreads();
}

__global__ void __launch_bounds__(512, 2) fwd_megakernel(Params p) {
  cg::grid_group grid = cg::this_grid();
  __shared__ __attribute__((aligned(16))) char smem[SMEM_BYTES];
  __shared__ int s_item;
  __shared__ uint4 xb_words;
  if (threadIdx.x == 0) xb_words = make_uint4(0u, 0u, 0u, 0u);
  __syncthreads();
  const XcdBarrier xb = xcd_barrier_post((unsigned*)(p.ws + W_BAR), (volatile LAS unsigned*)&xb_words);
  if (p.ws == nullptr) grid.sync();
  phase0(p, smem);
  xcd_barrier(xb);
  phase1(p, smem);
  xcd_barrier(xb);
  phase2(p);
  xcd_barrier(xb);
  phase3(p, smem);
  xcd_barrier(xb);
  phase4(p, smem, &s_item);
  xcd_barrier(xb);
  phase5(p, smem);
  xcd_barrier(xb);
  phase_ln(p, p.in[16], p.in[17], (u16*)(p.ws + W_X1B));
  xcd_barrier(xb);
  phase7(p, smem);
  xcd_barrier(xb);
  phase9(p, smem);
  xcd_barrier(xb);
  phase_ln(p, p.in[24], p.in[25], nullptr);
}

extern "C" void kernel_launch(void* const* d_in, const int* in_sizes, int n_in, void* d_out, int out_size,
                              void* d_ws, size_t ws_size, hipStream_t stream) {
  static int grid_blocks = 0;
  if (!grid_blocks) {
    int dev = 0, cus = 0, per_cu = 0;
    hipGetDevice(&dev);
    hipDeviceGetAttribute(&cus, hipDeviceAttributeMultiprocessorCount, dev);
    hipOccupancyMaxActiveBlocksPerMultiprocessor(&per_cu, fwd_megakernel, 512, 0);
    if (per_cu > 1) per_cu = 1;
    if (per_cu < 1) per_cu = 1;
    grid_blocks = cus * per_cu;
    if (ws_size < W_TOTAL) fprintf(stderr, "workspace too small: %zu < %zu\n", ws_size, (size_t)W_TOTAL);
  }
  Params p{};
  for (int i = 0; i < 26; ++i) p.in[i] = (const float*)d_in[i];
  p.out = (float*)d_out;
  p.ws = (char*)d_ws;
  (void)hipMemsetAsync((char*)d_ws + W_BAR, 0, 16384, stream);
  void* args[] = {&p};
  hipError_t e = hipLaunchCooperativeKernel((void*)fwd_megakernel, dim3(grid_blocks), dim3(512), args, 0, stream);
  if (e != hipSuccess) fprintf(stderr, "cooperative launch failed: %s (grid %d)\n", hipGetErrorString(e), grid_blocks);
}
```
